# Optimizing an MI355X kernel written in HIP

```python
import math
import jax, jax.numpy as jnp
from jax import lax
import numpy as np

D_MODEL = 1024
BATCH = 8
SEQ = 2048
DEPTH = 1
DEC_BATCH = 128
DEC_SEQ = 1
PAST_LEN = 16384
PAGE_SIZE = 128

S5_WIDTH = D_MODEL // 2
S5_GROUP = 16
S5_GROUPS = S5_WIDTH // S5_GROUP
S5_STATE = 64
DT_MIN = 1e-3
DT_MAX = 1e-1
RWKV_HEAD = 64
RWKV_WIDTH = D_MODEL // 2
RWKV_HEADS = RWKV_WIDTH // RWKV_HEAD
W_LORA = 64
A_LORA = 64
G_LORA = 128
N_SHIFT = 3 * RWKV_WIDTH + W_LORA + A_LORA + G_LORA
RWKV_SPLITS = (RWKV_WIDTH, 2 * RWKV_WIDTH, 3 * RWKV_WIDTH, 3 * RWKV_WIDTH + W_LORA, 3 * RWKV_WIDTH + W_LORA + A_LORA)
N_IN = S5_WIDTH + N_SHIFT + 2 * D_MODEL
D_FF = 128 * ((8 * D_MODEL // 3 + 127) // 128)
N_MOD = 9
NORM_EPS = 1e-6
GN_EPS = 64e-5

kernel_name = 'hybrid_s5_rwkv7_macaron_adaln_step'


def _rmsnorm(x, g):
    xf = x.astype(jnp.float32)
    xf = xf * lax.rsqrt(jnp.mean(xf * xf, axis=-1, keepdims=True) + NORM_EPS)
    return (xf * g).astype(x.dtype)


def _modulate(n, shift, scale):
    return n * (1 + scale) + shift


def _swiglu(x, w1, w3, w2):
    return (jax.nn.silu(x @ w1) * (x @ w3)) @ w2


def _s5_branch(u, h_re0, h_im0, p):
    f32 = jnp.float32
    bn, length, _ = u.shape
    uf = u.astype(f32)
    ug = uf.reshape(bn, length, S5_GROUPS, S5_GROUP)
    dt = jnp.exp(p['s5_log_dt'].astype(f32))[:, None]
    lam_re = p['s5_lam_re'].astype(f32)
    lam_im = p['s5_lam_im'].astype(f32)
    mag = jnp.exp(lam_re * dt)
    ang = lam_im * dt
    lb_re = mag * jnp.cos(ang)
    lb_im = mag * jnp.sin(ang)
    den = lam_re * lam_re + lam_im * lam_im
    num_re = lb_re - 1
    k_re = (num_re * lam_re + lb_im * lam_im) / den
    k_im = (lb_im * lam_re - num_re * lam_im) / den
    b_re = p['s5_b_re'].astype(f32)
    b_im = p['s5_b_im'].astype(f32)
    bb_re = k_re[..., None] * b_re - k_im[..., None] * b_im
    bb_im = k_re[..., None] * b_im + k_im[..., None] * b_re
    bu_re = jnp.einsum('blgc,gnc->blgn', ug, bb_re)
    bu_im = jnp.einsum('blgc,gnc->blgn', ug, bb_im)
    h_re0 = h_re0.astype(f32)
    h_im0 = h_im0.astype(f32)
    bu_re = bu_re.at[:, 0].add(lb_re * h_re0 - lb_im * h_im0)
    bu_im = bu_im.at[:, 0].add(lb_re * h_im0 + lb_im * h_re0)
    a_re = jnp.broadcast_to(lb_re, bu_re.shape)
    a_im = jnp.broadcast_to(lb_im, bu_im.shape)

    def combine(e1, e2):
        a1r, a1i, b1r, b1i = e1
        a2r, a2i, b2r, b2i = e2
        return (a1r * a2r - a1i * a2i,
                a1r * a2i + a1i * a2r,
                a2r * b1r - a2i * b1i + b2r,
                a2r * b1i + a2i * b1r + b2i)

    _, _, xs_re, xs_im = lax.associative_scan(combine, (a_re, a_im, bu_re, bu_im), axis=1)
    y = (jnp.einsum('blgn,gcn->blgc', xs_re, p['s5_c_re'].astype(f32))
         - jnp.einsum('blgn,gcn->blgc', xs_im, p['s5_c_im'].astype(f32)))
    y = y.reshape(bn, length, S5_WIDTH) + p['s5_d'] * uf
    z = jax.nn.gelu(y)
    out = (z @ p['s5_glu_v']) * jax.nn.sigmoid(z @ p['s5_glu_g'])
    return out.astype(u.dtype), xs_re[:, -1], xs_im[:, -1]


def _wkv7_step(s, inp):
    r, dec, k, v, a, b = inp
    sa = jnp.einsum('bhij,bhj->bhi', s, a)
    s = s * dec[:, :, None, :] + sa[..., None] * b[:, :, None, :] + v[..., None] * k[:, :, None, :]
    return s, jnp.einsum('bhij,bhj->bhi', s, r)


def _rwkv_branch(mixed, wkv0, p):
    f32 = jnp.float32
    bn, length, _ = mixed.shape
    mf = mixed.astype(f32)
    r, k, v, wd, ad, gd = jnp.split(mf, RWKV_SPLITS, axis=-1)
    w = -jax.nn.softplus(-(p['rwkv_w0'] + jnp.tanh(wd) @ p['rwkv_w2'])) - 0.5
    decay = jnp.exp(-jnp.exp(w))
    a = jax.nn.sigmoid(p['rwkv_a0'] + ad @ p['rwkv_a2'])
    g = jax.nn.sigmoid(gd) @ p['rwkv_g2']
    hs = (bn, length, RWKV_HEADS, RWKV_HEAD)
    kk = (k * p['rwkv_k_k']).reshape(hs)
    kk = kk / jnp.maximum(jnp.sqrt(jnp.sum(kk * kk, axis=-1, keepdims=True)), 1e-12)
    k = k * (1 + (a - 1) * p['rwkv_k_a'])
    r_h = r.reshape(hs)
    k_h = k.reshape(hs)
    v_h = v.reshape(hs)
    d_h = decay.reshape(hs)
    a_h = a.reshape(hs)
    xs = tuple(jnp.moveaxis(t, 1, 0) for t in (r_h, d_h, k_h, v_h, -kk, kk * a_h))
    s_fin, ys = lax.scan(_wkv7_step, wkv0.astype(f32), xs)
    y = jnp.moveaxis(ys, 0, 1)
    mean = jnp.mean(y, axis=-1, keepdims=True)
    var = jnp.mean(jnp.square(y - mean), axis=-1, keepdims=True)
    yn = ((y - mean) * lax.rsqrt(var + GN_EPS)).reshape(bn, length, RWKV_WIDTH)
    yn = yn * p['rwkv_ln_w'] + p['rwkv_ln_b']
    bonus = (jnp.sum(r_h * k_h * p['rwkv_r_k'], axis=-1, keepdims=True) * v_h).reshape(bn, length, RWKV_WIDTH)
    o = (yn + bonus) * g
    return (o @ p['rwkv_proj']).astype(mixed.dtype), s_fin


def _layer(x, c, s5_re0, s5_im0, wkv0, shift0, p):
    mod = (jax.nn.silu(c) @ p['w_ada'] + p['b_ada']).reshape(c.shape[0], N_MOD, 1, D_MODEL)
    sh1, sc1, gt1, sh2, sc2, gt2, sh3, sc3, gt3 = [mod[:, i] for i in range(N_MOD)]
    h = x
    n = _modulate(_rmsnorm(h, p['g_ffn1']), sh1, sc1)
    h = h + 0.5 * gt1 * _swiglu(n, p['ffn1_w1'], p['ffn1_w3'], p['ffn1_w2'])
    u = _modulate(_rmsnorm(h, p['g_mix']), sh2, sc2)
    proj = u @ p['w_in']
    s5_in = proj[..., :S5_WIDTH]
    cur = proj[..., S5_WIDTH:S5_WIDTH + N_SHIFT]
    gates = proj[..., S5_WIDTH + N_SHIFT:]
    prev = jnp.concatenate([shift0[:, None, :].astype(cur.dtype), cur[:, :-1]], axis=1)
    mixed = cur + p['mu_shift'] * (prev - cur)
    y_s5, s5_re1, s5_im1 = _s5_branch(s5_in, s5_re0, s5_im0, p)
    y_rwkv, wkv1 = _rwkv_branch(mixed, wkv0, p)
    m = jax.nn.sigmoid(gates[..., :D_MODEL]) * y_s5 + jax.nn.sigmoid(gates[..., D_MODEL:]) * y_rwkv
    h = h + gt2 * (m @ p['w_out'])
    n = _modulate(_rmsnorm(h, p['g_ffn2']), sh3, sc3)
    h = h + 0.5 * gt3 * _swiglu(n, p['ffn2_w1'], p['ffn2_w3'], p['ffn2_w2'])
    y = _rmsnorm(h, p['g_final']).astype(x.dtype)
    sd = s5_re0.dtype
    return (y, s5_re1.astype(sd), s5_im1.astype(sd), wkv1.astype(wkv0.dtype),
            cur[:, -1].astype(shift0.dtype))


def setup_inputs(seed: int = 0) -> dict:
    key = jax.random.key(seed)
    ks = iter(jax.random.split(key, 64))
    f32 = jnp.float32

    def nrm(shape, s):
        return jax.random.normal(next(ks), shape, f32) * s

    def uni(shape, lo, hi):
        return jax.random.uniform(next(ks), shape, f32, lo, hi)

    d = D_MODEL
    g, n = S5_GROUPS, S5_STATE
    return {
        'x_prompt': nrm((BATCH, SEQ, d), 1.0),
        'x_sample': nrm((DEC_BATCH, DEC_SEQ, d), 1.0),
        'c_prompt': nrm((BATCH, d), 1.0),
        'c_sample': nrm((DEC_BATCH, d), 1.0),
        'state_s5_re': nrm((DEC_BATCH, g, n), 0.3),
        'state_s5_im': nrm((DEC_BATCH, g, n), 0.3),
        'state_wkv': nrm((DEC_BATCH, RWKV_HEADS, RWKV_HEAD, RWKV_HEAD), 0.3),
        'state_shift': nrm((DEC_BATCH, N_SHIFT), 1.0),
        'w_ada': nrm((d, N_MOD * d), 0.3 * d ** -0.5),
        'b_ada': nrm((N_MOD * d,), 0.01),
        'g_ffn1': 1.0 + nrm((d,), 0.02),
        'g_mix': 1.0 + nrm((d,), 0.02),
        'g_ffn2': 1.0 + nrm((d,), 0.02),
        'g_final': 1.0 + nrm((d,), 0.02),
        'ffn1_w1': nrm((d, D_FF), d ** -0.5),
        'ffn1_w3': nrm((d, D_FF), d ** -0.5),
        'ffn1_w2': nrm((D_FF, d), D_FF ** -0.5),
        'ffn2_w1': nrm((d, D_FF), d ** -0.5),
        'ffn2_w3': nrm((d, D_FF), d ** -0.5),
        'ffn2_w2': nrm((D_FF, d), D_FF ** -0.5),
        'w_in': nrm((d, N_IN), d ** -0.5),
        'mu_shift': uni((N_SHIFT,), 0.0, 1.0),
        's5_lam_re': -0.5 + nrm((g, n), 0.005),
        's5_lam_im': jnp.pi * jnp.arange(n, dtype=f32)[None, :] + nrm((g, n), 0.01),
        's5_log_dt': uni((g,), math.log(DT_MIN), math.log(DT_MAX)),
        's5_b_re': nrm((g, n, S5_GROUP), (2 * S5_GROUP) ** -0.5),
        's5_b_im': nrm((g, n, S5_GROUP), (2 * S5_GROUP) ** -0.5),
        's5_c_re': nrm((g, S5_GROUP, n), n ** -0.5),
        's5_c_im': nrm((g, S5_GROUP, n), n ** -0.5),
        's5_d': nrm((S5_WIDTH,), 1.0),
        's5_glu_v': nrm((S5_WIDTH, d), S5_WIDTH ** -0.5),
        's5_glu_g': nrm((S5_WIDTH, d), S5_WIDTH ** -0.5),
        'rwkv_w0': uni((RWKV_WIDTH,), -6.0, 1.0),
        'rwkv_w2': nrm((W_LORA, RWKV_WIDTH), 0.1 * W_LORA ** -0.5),
        'rwkv_a0': nrm((RWKV_WIDTH,), 0.1),
        'rwkv_a2': nrm((A_LORA, RWKV_WIDTH), 0.1 * A_LORA ** -0.5),
        'rwkv_g2': nrm((G_LORA, RWKV_WIDTH), G_LORA ** -0.5),
        'rwkv_k_k': 0.85 + nrm((RWKV_WIDTH,), 0.02),
        'rwkv_k_a': 1.0 + nrm((RWKV_WIDTH,), 0.02),
        'rwkv_r_k': nrm((RWKV_HEADS, RWKV_HEAD), 0.1),
        'rwkv_ln_w': 1.0 + nrm((RWKV_WIDTH,), 0.02),
        'rwkv_ln_b': nrm((RWKV_WIDTH,), 0.01),
        'rwkv_proj': nrm((RWKV_WIDTH, d), RWKV_WIDTH ** -0.5),
        'w_out': nrm((d, d), d ** -0.5),
    }


def reference(x_prompt, x_sample, c_prompt, c_sample, state_s5_re, state_s5_im, state_wkv, state_shift,
              w_ada, b_ada, g_ffn1, g_mix, g_ffn2, g_final,
              ffn1_w1, ffn1_w3, ffn1_w2, ffn2_w1, ffn2_w3, ffn2_w2,
              w_in, mu_shift,
              s5_lam_re, s5_lam_im, s5_log_dt, s5_b_re, s5_b_im, s5_c_re, s5_c_im, s5_d, s5_glu_v, s5_glu_g,
              rwkv_w0, rwkv_w2, rwkv_a0, rwkv_a2, rwkv_g2, rwkv_k_k, rwkv_k_a, rwkv_r_k,
              rwkv_ln_w, rwkv_ln_b, rwkv_proj, w_out):
    p = dict(w_ada=w_ada, b_ada=b_ada, g_ffn1=g_ffn1, g_mix=g_mix, g_ffn2=g_ffn2, g_final=g_final,
             ffn1_w1=ffn1_w1, ffn1_w3=ffn1_w3, ffn1_w2=ffn1_w2,
             ffn2_w1=ffn2_w1, ffn2_w3=ffn2_w3, ffn2_w2=ffn2_w2,
             w_in=w_in, mu_shift=mu_shift,
             s5_lam_re=s5_lam_re, s5_lam_im=s5_lam_im, s5_log_dt=s5_log_dt,
             s5_b_re=s5_b_re, s5_b_im=s5_b_im, s5_c_re=s5_c_re, s5_c_im=s5_c_im,
             s5_d=s5_d, s5_glu_v=s5_glu_v, s5_glu_g=s5_glu_g,
             rwkv_w0=rwkv_w0, rwkv_w2=rwkv_w2, rwkv_a0=rwkv_a0, rwkv_a2=rwkv_a2, rwkv_g2=rwkv_g2,
             rwkv_k_k=rwkv_k_k, rwkv_k_a=rwkv_k_a, rwkv_r_k=rwkv_r_k,
             rwkv_ln_w=rwkv_ln_w, rwkv_ln_b=rwkv_ln_b, rwkv_proj=rwkv_proj, w_out=w_out)
    bp = x_prompt.shape[0]
    z_s5 = jnp.zeros((bp, S5_GROUPS, S5_STATE), state_s5_re.dtype)
    z_wkv = jnp.zeros((bp, RWKV_HEADS, RWKV_HEAD, RWKV_HEAD), state_wkv.dtype)
    z_shift = jnp.zeros((bp, N_SHIFT), state_shift.dtype)
    y_prompt, s5_re_p, s5_im_p, wkv_p, shift_p = _layer(x_prompt, c_prompt, z_s5, z_s5, z_wkv, z_shift, p)
    y_sample, s5_re_s, s5_im_s, wkv_s, shift_s = _layer(x_sample, c_sample, state_s5_re, state_s5_im,
                                                        state_wkv, state_shift, p)
    return (y_prompt, y_sample, s5_re_p, s5_im_p, wkv_p, shift_p, s5_re_s, s5_im_s, wkv_s, shift_s)
```

```cpp
#include <hip/hip_runtime.h>
#include <cstdio>
#include <cstdint>
namespace pg8 {
#define PG8_LAS __attribute__((address_space(3)))
typedef unsigned short bf16_t;
typedef short bf16x8 __attribute__((ext_vector_type(8)));
typedef float f32x4 __attribute__((ext_vector_type(4)));
typedef unsigned u32x4 __attribute__((ext_vector_type(4)));
constexpr int BM = 256, BK = 64, HALF = 128, HTB = HALF * BK * 2  , STAGE_BYTES = 8 * HTB, NXCD = 8, WGM = 8;

__host__ __device__ __forceinline__ int lds_byte(int r, int c) { const int st = (r >> 4) * 2 + (c >> 5), rr = r & 15, cc = c & 31, ob = rr * 64 + cc * 2; return st * 1024 + (ob ^ (((ob >> 9) & 1) << 5)); }
__host__ __device__ __forceinline__ void stage_rc(int b, int& R, int& C) { const int st = b / 1024, sb = b % 1024, swz = sb ^ (((sb >> 9) & 1) << 5); R = (st >> 1) * 16 + swz / 64; C = (st & 1) * 32 + (swz % 64) / 2; }
__host__ __device__ __forceinline__ int perm32(int rho) { const int n = rho >> 4, i = rho & 15; return 8 * (i >> 2) + 4 * n + (i & 3); }

struct Unit { int pm, pn, ko, nt, kind; };
struct Gemm { const bf16_t* A[3]; const bf16_t* Bt[3]; int M, N, K, ld, ld1; };

struct StaticOrder {
    int nM, nN, nwg, G, c;
    __host__ __device__ void init(int M, int N, int G_, int c_) { nM = M / BM; nN = N / BM; nwg = nM * nN; G = G_; c = c_; }
    __host__ __device__ bool next(int i, Unit& u) const {
        const long L = (long)i * G + c; if (L >= nwg) return false;
        int wgid = (int)L; { const int q = nwg / NXCD, r = nwg % NXCD, xcd = wgid % NXCD, off = wgid / NXCD; wgid = (xcd < r ? xcd * (q + 1) : r * (q + 1) + (xcd - r) * q) + off; }
        const int nig = WGM * nN, gid = wgid / nig, fm = gid * WGM, gsz = (nM - fm) < WGM ? (nM - fm) : WGM;
        u.pm = fm + ((wgid % nig) % gsz); u.pn = (wgid % nig) / gsz; u.ko = 0; u.nt = 0; u.kind = 0; return true;
    }
    __device__ __forceinline__ void a_ready(const Unit&) const {}
    __device__ __forceinline__ void done(const Unit&) const {}
};


struct ExtOrder : StaticOrder {
    int base_nwg, extra, xm, xn0;
    __host__ __device__ void init2(int M, int N, int G_, int c_, int extra_, int xm_, int xn0_) { init(M, N, G_, c_); base_nwg = nwg; extra = extra_; xm = xm_; xn0 = xn0_; }
    __host__ __device__ bool next(int i, Unit& u) const {
        const long L = (long)i * G + c;
        if (L < base_nwg) return StaticOrder::next(i, u);
        if (L >= base_nwg + extra) return false;
        u.pm = xm; u.pn = xn0 + (int)(L - base_nwg); u.ko = 0; u.nt = 0; u.kind = 0; return true;
    }
};
struct SliceOrder {
    int nN, nsub, G, c, pm, ks;
    __host__ __device__ void init(int nN_, int nslices, int G_, int c_, int pm_, int ks_) { nN = nN_; nsub = nN_ * nslices; G = G_; c = c_; pm = pm_; ks = ks_; }
    __host__ __device__ bool next(int i, Unit& u) const {
        const int s = G - 1 - c + i * G; if (s >= nsub || s < 0) return false;
        u.pm = pm; u.pn = s % nN; u.ko = (s / nN) * ks; u.nt = ks / BK; u.kind = 0; return true;
    }
    __device__ __forceinline__ void a_ready(const Unit&) const {}
    __device__ __forceinline__ void done(const Unit&) const {}
};

struct MainPlusSlice : StaticOrder {
    SliceOrder sl;
    __host__ __device__ void init3(int M, int N, int G_, int c_, int nslices, int pm_, int ks_) { init(M, N, G_, c_); sl.init(N / BM, nslices, G_, c_, pm_, ks_); }
    __host__ __device__ bool next(int i, Unit& u) const {
        if (i == 0) { if (StaticOrder::next(0, u)) return true; return sl.next(0, u); }
        if (i == 1 && c < nwg) return sl.next(0, u);
        return false;
    }
};

struct ChainOrder {
    int G, c, xm;
    __host__ __device__ void init(int G_, int c_, int xm_) { G = G_; c = c_; xm = xm_; }
    __host__ __device__ bool next(int i, Unit& u) const {
        const int x = c % NXCD, j = c / NXCD;
        int pm = x * (G / NXCD / 4) + (j >> 2), q = j & 3, k = i;
        if (i >= 5) return false;
        u.pm = pm; u.ko = 0;
        if (k == 0) { u.kind = 0; u.pn = 9 + 4 + q; u.nt = 16; }
        else if (k == 1) { u.kind = 1; u.pn = q; u.nt = 8; u.ko = 512; }
        else if (k == 2) { u.kind = 0; u.pn = 9 + q; u.nt = 16; }
        else { u.kind = 2; u.pn = 2 * q + (k - 3); u.nt = 8; }
        return true;
    }
    __device__ __forceinline__ void a_ready(const Unit&) const {}
    __device__ __forceinline__ void done(const Unit&) const {}
};
typedef float f32x2n __attribute__((ext_vector_type(2)));
typedef __bf16 bf16x2n __attribute__((ext_vector_type(2)));
__device__ __forceinline__ unsigned cvt_pk_bf16(float lo, float hi) { const f32x2n v = {lo, hi}; return __builtin_bit_cast(unsigned, __builtin_convertvector(v, bf16x2n)); }
__device__ __forceinline__ float bflo(unsigned w) { return __uint_as_float(w << 16); }
__device__ __forceinline__ float bfhi(unsigned w) { return __uint_as_float(w & 0xffff0000u); }
__device__ __forceinline__ float fsigmoid(float x) { return __builtin_amdgcn_rcpf(1.0f + __expf(-x)); }
constexpr int E_MP = 16384, E_M = 16512, E_NB = 136, E_NMOD = 9216;
__device__ __forceinline__ int row_batch(int r) { int b = r < E_MP ? (r >> 11) : 8 + (r - E_MP); return b < E_NB ? b : E_NB - 1; }

struct EpiMod {
    static constexpr bool PERM = false, AFTER_DRAIN = false;
    float* out; const float* bias;
    __device__ __forceinline__ void operator()(const f32x4 (&acc)[2][2][4][2], const Unit& u, int wr, int wc, int fr, int fq) const {
        const int row0 = u.pm * BM + wr * 64 + fr, col0 = u.pn * BM + wc * 32 + 4 * fq;
#pragma unroll
        for (int ai = 0; ai < 2; ++ai)
#pragma unroll
            for (int m = 0; m < 4; ++m) { const int row = row0 + ai * HALF + m * 16;
                if (row < E_NB) {
#pragma unroll
                    for (int bj = 0; bj < 2; ++bj)
#pragma unroll
                        for (int n = 0; n < 2; ++n) { const int col = col0 + bj * HALF + n * 16; const f32x4 bv = *(const f32x4*)(bias + col);
                            *(f32x4*)(out + (size_t)row * E_NMOD + col) = acc[ai][bj][m][n] + bv; } } }
    }
};
struct EpiSwiglu {
    static constexpr bool PERM = true, AFTER_DRAIN = false;
    bf16_t* O; int ldc;
    __device__ __forceinline__ void operator()(const f32x4 (&acc)[2][2][4][2], const Unit& u, int wr, int wc, int fr, int fq) const {
        const int row0 = u.pm * BM + wr * 64 + fr, col0 = u.pn * HALF + wc * 32 + 8 * fq;
#pragma unroll
        for (int ai = 0; ai < 2; ++ai)
#pragma unroll
            for (int m = 0; m < 4; ++m) { bf16_t* rowp = O + (size_t)(row0 + ai * HALF + m * 16) * ldc + col0;
                float o[8];
#pragma unroll
                for (int n = 0; n < 2; ++n)
#pragma unroll
                    for (int i = 0; i < 4; ++i) { const float a = acc[ai][0][m][n][i], g = acc[ai][1][m][n][i]; o[4 * n + i] = a * fsigmoid(a) * g; }
                u32x4 w; w.x = cvt_pk_bf16(o[0], o[1]); w.y = cvt_pk_bf16(o[2], o[3]); w.z = cvt_pk_bf16(o[4], o[5]); w.w = cvt_pk_bf16(o[6], o[7]);
#ifdef NT_STORES
                __builtin_nontemporal_store(w, (u32x4*)rowp);
#else
                *(u32x4*)rowp = w;
#endif
                }
    }
};
constexpr int E_HP = 2048;
struct EpiRes {
    static constexpr bool PERM = true, AFTER_DRAIN = false;
    const float* base_p; const float* base_s; bf16_t* hb; const float* mod; int gidx; float scale;
    __device__ __forceinline__ void operator()(const f32x4 (&acc)[2][2][4][2], const Unit& u, int wr, int wc, int fr, int fq) const {
        const int row0 = u.pm * BM + wr * 64 + fr, col0 = u.pn * BM + wc * 32 + 8 * fq;
        const float* gp = mod + (size_t)((u.pm * BM) >> 11) * E_NMOD + gidx * 1024 + col0;
        f32x4 g[2][2];
#pragma unroll
        for (int bj = 0; bj < 2; ++bj) { g[bj][0] = *(const f32x4*)(gp + bj * HALF) * scale; g[bj][1] = *(const f32x4*)(gp + bj * HALF + 4) * scale; }
#pragma unroll
        for (int ai = 0; ai < 2; ++ai) {
            f32x4 b[4][2][2];
            if (base_p) {
#pragma unroll
                for (int m = 0; m < 4; ++m)
#pragma unroll
                    for (int bj = 0; bj < 2; ++bj) { const float* bp = base_p + (size_t)(row0 + ai * HALF + m * 16) * 1024 + col0 + bj * HALF; b[m][bj][0] = *(const f32x4*)bp; b[m][bj][1] = *(const f32x4*)(bp + 4); }
            } else {
                u32x4 h[4][2];
#pragma unroll
                for (int m = 0; m < 4; ++m)
#pragma unroll
                    for (int bj = 0; bj < 2; ++bj) h[m][bj] = *(const u32x4*)(hb + (size_t)(row0 + ai * HALF + m * 16) * E_HP + col0 + bj * HALF);
#pragma unroll
                for (int m = 0; m < 4; ++m)
#pragma unroll
                    for (int bj = 0; bj < 2; ++bj) { const u32x4 x = h[m][bj]; b[m][bj][0] = (f32x4){bflo(x.x), bfhi(x.x), bflo(x.y), bfhi(x.y)}; b[m][bj][1] = (f32x4){bflo(x.z), bfhi(x.z), bflo(x.w), bfhi(x.w)}; }
            }
#pragma unroll
            for (int m = 0; m < 4; ++m)
#pragma unroll
                for (int bj = 0; bj < 2; ++bj) {
                    const f32x4 o0 = b[m][bj][0] + g[bj][0] * acc[ai][bj][m][0], o1 = b[m][bj][1] + g[bj][1] * acc[ai][bj][m][1];
                    u32x4 w; w.x = cvt_pk_bf16(o0[0], o0[1]); w.y = cvt_pk_bf16(o0[2], o0[3]); w.z = cvt_pk_bf16(o1[0], o1[1]); w.w = cvt_pk_bf16(o1[2], o1[3]);
                    *(u32x4*)(hb + (size_t)(row0 + ai * HALF + m * 16) * E_HP + col0 + bj * HALF) = w; }
        }
    }
};
struct EpiWin {
    static constexpr bool PERM = true, AFTER_DRAIN = false;
    bf16_t* s5in; bf16_t* cur; bf16_t* gates; int pn_off;
    __device__ __forceinline__ void operator()(const f32x4 (&acc)[2][2][4][2], const Unit& u, int wr, int wc, int fr, int fq) const {
        bf16_t* base; int ld, colt; bool sg = false;
        const int pn = u.pn + pn_off;
        if (pn < 2) { base = s5in; ld = 512; colt = pn * BM; } else if (pn < 9) { base = cur; ld = 1792; colt = (pn - 2) * BM; } else { base = gates; ld = 2048; colt = (pn - 9) * BM; sg = true; }
        const int row0 = u.pm * BM + wr * 64 + fr, col0 = colt + wc * 32 + 8 * fq;
#pragma unroll
        for (int ai = 0; ai < 2; ++ai)
#pragma unroll
            for (int m = 0; m < 4; ++m) { bf16_t* rowp = base + (size_t)(row0 + ai * HALF + m * 16) * ld + col0;
#pragma unroll
                for (int bj = 0; bj < 2; ++bj) { f32x4 v0 = acc[ai][bj][m][0], v1 = acc[ai][bj][m][1];
                    if (sg) {
#pragma unroll
                        for (int i = 0; i < 4; ++i) { v0[i] = fsigmoid(v0[i]); v1[i] = fsigmoid(v1[i]); } }
                    u32x4 w; w.x = cvt_pk_bf16(v0[0], v0[1]); w.y = cvt_pk_bf16(v0[2], v0[3]); w.z = cvt_pk_bf16(v1[0], v1[1]); w.w = cvt_pk_bf16(v1[2], v1[3]);
                    *(u32x4*)(rowp + bj * HALF) = w; } }
    }
};
struct EpiYr {
    static constexpr bool PERM = true, AFTER_DRAIN = false;
    const bf16_t* gates; bf16_t* mixp;
    __device__ __forceinline__ void operator()(const f32x4 (&acc)[2][2][4][2], const Unit& u, int wr, int wc, int fr, int fq) const {
        const int row0 = u.pm * BM + wr * 64 + fr, col0 = u.pn * BM + wc * 32 + 8 * fq;
        u32x4 g[2][4][2];
#pragma unroll
        for (int ai = 0; ai < 2; ++ai)
#pragma unroll
            for (int m = 0; m < 4; ++m)
#pragma unroll
                for (int bj = 0; bj < 2; ++bj) g[ai][m][bj] = *(const u32x4*)(gates + (size_t)(row0 + ai * HALF + m * 16) * 2048 + 1024 + col0 + bj * HALF);
#pragma unroll
        for (int ai = 0; ai < 2; ++ai)
#pragma unroll
            for (int m = 0; m < 4; ++m) { const size_t row = (size_t)(row0 + ai * HALF + m * 16);
#pragma unroll
                for (int bj = 0; bj < 2; ++bj) { const int col = col0 + bj * HALF; const u32x4 gg = g[ai][m][bj];
                    const f32x4 v0 = acc[ai][bj][m][0], v1 = acc[ai][bj][m][1];
                    u32x4 w; w.x = cvt_pk_bf16(v0[0] * bflo(gg.x), v0[1] * bfhi(gg.x)); w.y = cvt_pk_bf16(v0[2] * bflo(gg.y), v0[3] * bfhi(gg.y));
                    w.z = cvt_pk_bf16(v1[0] * bflo(gg.z), v1[1] * bfhi(gg.z)); w.w = cvt_pk_bf16(v1[2] * bflo(gg.w), v1[3] * bfhi(gg.w));
                    *(u32x4*)(mixp + row * 1024 + col) = w; } }
    }
};
struct EpiGlu {
    static constexpr bool PERM = true, AFTER_DRAIN = false;
    const bf16_t* gates; const bf16_t* mixp; bf16_t* mm;
    __device__ __forceinline__ void operator()(const f32x4 (&acc)[2][2][4][2], const Unit& u, int wr, int wc, int fr, int fq) const {
        const int row0 = u.pm * BM + wr * 64 + fr, col = u.pn * HALF + wc * 32 + 8 * fq;
        u32x4 g[2][4], p[2][4];
#pragma unroll
        for (int ai = 0; ai < 2; ++ai)
#pragma unroll
            for (int m = 0; m < 4; ++m) { const size_t row = (size_t)(row0 + ai * HALF + m * 16); g[ai][m] = *(const u32x4*)(gates + row * 2048 + col); p[ai][m] = *(const u32x4*)(mixp + row * 1024 + col); }
#pragma unroll
        for (int ai = 0; ai < 2; ++ai)
#pragma unroll
            for (int m = 0; m < 4; ++m) { const size_t row = (size_t)(row0 + ai * HALF + m * 16);
                const u32x4 gg = g[ai][m], pp = p[ai][m];
                float o[8];
#pragma unroll
                for (int n = 0; n < 2; ++n)
#pragma unroll
                    for (int i = 0; i < 4; ++i) o[4 * n + i] = acc[ai][0][m][n][i] * fsigmoid(acc[ai][1][m][n][i]);
                u32x4 w; w.x = cvt_pk_bf16(o[0] * bflo(gg.x) + bflo(pp.x), o[1] * bfhi(gg.x) + bfhi(pp.x)); w.y = cvt_pk_bf16(o[2] * bflo(gg.y) + bflo(pp.y), o[3] * bfhi(gg.y) + bfhi(pp.y));
                w.z = cvt_pk_bf16(o[4] * bflo(gg.z) + bflo(pp.z), o[5] * bfhi(gg.z) + bfhi(pp.z)); w.w = cvt_pk_bf16(o[6] * bflo(gg.w) + bflo(pp.w), o[7] * bfhi(gg.w) + bfhi(pp.w));
                *(u32x4*)(mm + row * 1024 + col) = w; }
    }
};

struct EpiSlab {
    static constexpr bool PERM = true, AFTER_DRAIN = false;
    float* slab; const float* mod; int gidx; float scale; int ks;
    __device__ __forceinline__ void operator()(const f32x4 (&acc)[2][2][4][2], const Unit& u, int wr, int wc, int fr, int fq) const {
        const int row0 = u.pm * BM + wr * 64 + fr, col0 = u.pn * BM + wc * 32 + 8 * fq;
        float* sl = slab + (size_t)(u.ko / ks) * (E_M - E_MP) * 1024;
#pragma unroll
        for (int ai = 0; ai < 2; ++ai) {
            if (row0 + ai * HALF + 48 < E_M) {
                f32x4 g[4][2][2];
#pragma unroll
                for (int m = 0; m < 4; ++m) { const float* gp = mod + (size_t)row_batch(row0 + ai * HALF + m * 16) * E_NMOD + gidx * 1024 + col0;
#pragma unroll
                    for (int bj = 0; bj < 2; ++bj) { g[m][bj][0] = *(const f32x4*)(gp + bj * HALF); g[m][bj][1] = *(const f32x4*)(gp + bj * HALF + 4); } }
#pragma unroll
                for (int m = 0; m < 4; ++m) { float* op = sl + (size_t)(row0 + ai * HALF + m * 16 - E_MP) * 1024 + col0;
#pragma unroll
                    for (int bj = 0; bj < 2; ++bj)
#pragma unroll
                        for (int n = 0; n < 2; ++n) *(f32x4*)(op + bj * HALF + n * 4) = (g[m][bj][n] * scale) * acc[ai][bj][m][n]; }
            }
        }
    }
};
struct EpiResSlab {
    static constexpr bool PERM = true, AFTER_DRAIN = false;
    EpiRes a; EpiSlab s;
    __device__ __forceinline__ void operator()(const f32x4 (&acc)[2][2][4][2], const Unit& u, int wr, int wc, int fr, int fq) const { if (u.nt) s(acc, u, wr, wc, fr, fq); else a(acc, u, wr, wc, fr, fq); }
};
struct EpiChain {
    static constexpr bool PERM = true, AFTER_DRAIN = false;
    EpiWin w; EpiYr y; EpiGlu g;
    __device__ __forceinline__ void operator()(const f32x4 (&acc)[2][2][4][2], const Unit& u, int wr, int wc, int fr, int fq) const {
        if (u.kind == 0) w(acc, u, wr, wc, fr, fq); else if (u.kind == 1) y(acc, u, wr, wc, fr, fq); else g(acc, u, wr, wc, fr, fq);
    }
};
template <class Epi, class Sched, bool ALIGN_EPI = false, bool SP2 = false>
__device__ __forceinline__ void gemm_phase(PG8_LAS unsigned char* lds, const Gemm g, const Sched& S, const Epi& E) {
    const int tid = threadIdx.x, wid = __builtin_amdgcn_readfirstlane(tid >> 6), lane = tid & 63, wr = wid >> 2, wc = wid & 3, fr = lane & 15, fq = lane >> 4;
    const int K = g.ld, nt = g.K / BK;
    int vR[2], vRb[2], vC[2];
#pragma unroll
    for (int i = 0; i < 2; ++i) { int R, C; stage_rc(tid * 16 + i * 8192, R, C); vR[i] = R; vRb[i] = Epi::PERM ? ((R & ~31) + perm32(R & 31)) : R; vC[i] = C; }
#define PG8_LDOF(u_) (((u_).kind == 1 && g.ld1) ? g.ld1 : K)
#define PG8_SETLD(ld_, vA_, vB_, hs_) do { _Pragma("unroll") for (int _i = 0; _i < 2; ++_i) { vA_[_i] = (unsigned)(vR[_i] * (ld_) + vC[_i]) * 2u; vB_[_i] = (unsigned)(vRb[_i] * (ld_) + vC[_i]) * 2u; } hs_ = (size_t)HALF * (ld_) * 2; } while (0)
    unsigned voffA[2], voffB[2], voffAn[2], voffBn[2];
    size_t hstep, hstepn;
    const size_t kstep = (size_t)(BK * 2);
    const unsigned ldsw = (unsigned)wid * 1024u;
    const int aoff = lds_byte(wr * 64 + fr, fq * 8), boff = lds_byte(wc * 32 + fr, fq * 8);
#define PG8_SA(b, h) (((b) * 2 + (h)) * HTB)
#define PG8_SB(b, h) ((4 + (b) * 2 + (h)) * HTB)
#define PG8_STAGE(bufoff, gbase, voff) do { _Pragma("unroll") for (int _i = 0; _i < 2; ++_i) \
        __builtin_amdgcn_global_load_lds((const unsigned*)((const char*)(gbase) + (voff)[_i]), (PG8_LAS unsigned*)(lds + (bufoff) + ldsw + _i * 8192), 16, 0, 0); } while (0)
#define PG8_LDA(dst, b, h) do { _Pragma("unroll") for (int m = 0; m < 4; ++m) _Pragma("unroll") for (int k = 0; k < 2; ++k) dst[m][k] = *(const PG8_LAS bf16x8*)(lds + PG8_SA(b, h) + aoff + m * 2048 + k * 1024); } while (0)
#define PG8_LDB(dst, b, h) do { _Pragma("unroll") for (int n = 0; n < 2; ++n) _Pragma("unroll") for (int k = 0; k < 2; ++k) dst[n][k] = *(const PG8_LAS bf16x8*)(lds + PG8_SB(b, h) + boff + n * 2048 + k * 1024); } while (0)
#define PG8_MMA(ai, bj, At, Bt) do { __builtin_amdgcn_s_setprio(1); _Pragma("unroll") for (int m = 0; m < 4; ++m) _Pragma("unroll") for (int n = 0; n < 2; ++n) _Pragma("unroll") for (int k = 0; k < 2; ++k) \
        acc[ai][bj][m][n] = __builtin_amdgcn_mfma_f32_16x16x32_bf16(Bt[n][k], At[m][k], acc[ai][bj][m][n], 0, 0, 0); __builtin_amdgcn_s_setprio(0); } while (0)
#define PG8_WAIT_V(n) asm volatile("s_waitcnt vmcnt(" #n ")" ::: "memory")
#define PG8_WAIT_L(n) asm volatile("s_waitcnt lgkmcnt(" #n ")" ::: "memory")
#define PG8_BAR __builtin_amdgcn_s_barrier()
#define PG8_SCHED __builtin_amdgcn_sched_barrier(0)
    Unit cur, nxt; int ui = 0;
    if (!S.next(0, cur)) return;
    f32x4 acc[2][2][4][2];
#pragma unroll
    for (int a = 0; a < 2; ++a)
#pragma unroll
        for (int b = 0; b < 2; ++b)
#pragma unroll
            for (int m = 0; m < 4; ++m)
#pragma unroll
                for (int n = 0; n < 2; ++n) { acc[a][b][m][n] = (f32x4){0.f, 0.f, 0.f, 0.f}; asm volatile("" : "+v"(acc[a][b][m][n])); }
    bf16x8 At[4][2], B0[2][2], B1[2][2];
    PG8_SETLD(PG8_LDOF(cur), voffA, voffB, hstep);
    const char* cA = (const char*)(cur.kind == 0 ? g.A[0] : cur.kind == 1 ? g.A[1] : g.A[2]) + (size_t)cur.pm * (2 * hstep) + (size_t)cur.ko * 2; const char* cB = (const char*)(cur.kind == 0 ? g.Bt[0] : cur.kind == 1 ? g.Bt[1] : g.Bt[2]) + (size_t)cur.pn * (2 * hstep) + (size_t)cur.ko * 2;
    S.a_ready(cur);
    if constexpr (SP2) {
        PG8_STAGE(PG8_SB(0, 0), cB, voffB); PG8_STAGE(PG8_SB(0, 1), cB + hstep, voffB); PG8_STAGE(PG8_SA(0, 0), cA, voffA); PG8_STAGE(PG8_SA(0, 1), cA + hstep, voffA);
        if (wr == 1) PG8_BAR;
        PG8_WAIT_V(2); PG8_BAR;
        PG8_STAGE(PG8_SB(1, 0), cB + kstep, voffB); PG8_STAGE(PG8_SA(1, 0), cA + kstep, voffA); PG8_STAGE(PG8_SB(1, 1), cB + hstep + kstep, voffB);
        PG8_WAIT_V(6); PG8_BAR;
    } else {
        PG8_STAGE(PG8_SB(0, 0), cB, voffB); PG8_STAGE(PG8_SA(0, 0), cA, voffA); PG8_STAGE(PG8_SB(0, 1), cB + hstep, voffB); PG8_STAGE(PG8_SA(0, 1), cA + hstep, voffA);
        if (wr == 1) PG8_BAR;
        PG8_WAIT_V(4); PG8_BAR;
        PG8_STAGE(PG8_SB(1, 0), cB + kstep, voffB); PG8_STAGE(PG8_SA(1, 0), cA + kstep, voffA); PG8_STAGE(PG8_SB(1, 1), cB + hstep + kstep, voffB);
        PG8_WAIT_V(6); PG8_BAR;
    }
    for (;;) {
        const bool has_next = S.next(ui + 1, nxt);
        if (has_next) PG8_SETLD(PG8_LDOF(nxt), voffAn, voffBn, hstepn); else { voffAn[0] = voffA[0]; voffAn[1] = voffA[1]; voffBn[0] = voffB[0]; voffBn[1] = voffB[1]; hstepn = hstep; }
        const char* nA = has_next ? (const char*)(nxt.kind == 0 ? g.A[0] : nxt.kind == 1 ? g.A[1] : g.A[2]) + (size_t)nxt.pm * (2 * hstepn) + (size_t)nxt.ko * 2 : cA; const char* nB = has_next ? (const char*)(nxt.kind == 0 ? g.Bt[0] : nxt.kind == 1 ? g.Bt[1] : g.Bt[2]) + (size_t)nxt.pn * (2 * hstepn) + (size_t)nxt.ko * 2 : cB;
        const int unt = cur.nt ? cur.nt : nt;
        for (int t = 0; t < unt; t += 2) {
            const bool last = (t == unt - 2);
            const char* a1 = cA + (size_t)(t + 1) * kstep;
            const char* a2 = last ? nA : cA + (size_t)(t + 2) * kstep; const char* b2 = last ? nB : cB + (size_t)(t + 2) * kstep;
            const char* a3 = a2 + kstep; const char* b3 = b2 + kstep;
            unsigned vA2[2], vB2[2]; vA2[0] = last ? voffAn[0] : voffA[0]; vA2[1] = last ? voffAn[1] : voffA[1]; vB2[0] = last ? voffBn[0] : voffB[0]; vB2[1] = last ? voffBn[1] : voffB[1];
            const size_t hstep2 = last ? hstepn : hstep;
            if (last && has_next) S.a_ready(nxt);
            if constexpr (SP2) {
            PG8_LDB(B0, 0, 0); PG8_LDB(B1, 0, 1); PG8_SCHED; PG8_LDA(At, 0, 0); PG8_STAGE(PG8_SA(1, 1), a1 + hstep, voffA);
            PG8_WAIT_V(8); PG8_WAIT_L(0); PG8_BAR; PG8_MMA(0, 0, At, B0); PG8_MMA(0, 1, At, B1); PG8_BAR; PG8_SCHED;
            PG8_LDA(At, 0, 1); PG8_STAGE(PG8_SB(0, 0), b2, vB2); PG8_STAGE(PG8_SB(0, 1), b2 + hstep2, vB2); PG8_STAGE(PG8_SA(0, 0), a2, vA2);
            PG8_WAIT_V(8); PG8_WAIT_L(0); PG8_BAR; PG8_MMA(1, 0, At, B0); PG8_MMA(1, 1, At, B1); PG8_BAR; PG8_SCHED;
            PG8_LDB(B0, 1, 0); PG8_LDB(B1, 1, 1); PG8_SCHED; PG8_LDA(At, 1, 0); PG8_STAGE(PG8_SA(0, 1), a2 + hstep2, vA2);
            PG8_WAIT_V(8); PG8_WAIT_L(0); PG8_BAR; PG8_MMA(0, 0, At, B0); PG8_MMA(0, 1, At, B1); PG8_BAR; PG8_SCHED;
            PG8_LDA(At, 1, 1); PG8_STAGE(PG8_SB(1, 0), b3, vB2); PG8_STAGE(PG8_SB(1, 1), b3 + hstep2, vB2); PG8_STAGE(PG8_SA(1, 0), a3, vA2);
            PG8_WAIT_V(8); PG8_WAIT_L(0); PG8_BAR; PG8_MMA(1, 0, At, B0); PG8_MMA(1, 1, At, B1); PG8_BAR; PG8_SCHED;
            } else {
            PG8_LDB(B0, 0, 0); PG8_SCHED; PG8_LDA(At, 0, 0); PG8_STAGE(PG8_SA(1, 1), a1 + hstep, voffA);
            PG8_WAIT_L(8); PG8_BAR; PG8_WAIT_L(0); PG8_MMA(0, 0, At, B0); PG8_BAR; PG8_SCHED;
            PG8_LDB(B1, 0, 1); PG8_STAGE(PG8_SB(0, 0), b2, vB2);
            PG8_BAR; PG8_WAIT_L(0); PG8_MMA(0, 1, At, B1); PG8_BAR;
            PG8_LDA(At, 0, 1); PG8_STAGE(PG8_SA(0, 0), a2, vA2);
            PG8_BAR; PG8_WAIT_L(0); PG8_MMA(1, 0, At, B0); PG8_BAR; PG8_SCHED;
            PG8_STAGE(PG8_SB(0, 1), b2 + hstep2, vB2);
            PG8_WAIT_V(6); PG8_BAR; PG8_MMA(1, 1, At, B1); PG8_BAR;
            PG8_LDB(B0, 1, 0); PG8_SCHED; PG8_LDA(At, 1, 0); PG8_STAGE(PG8_SA(0, 1), a2 + hstep2, vA2);
            PG8_WAIT_L(8); PG8_BAR; PG8_WAIT_L(0); PG8_MMA(0, 0, At, B0); PG8_BAR; PG8_SCHED;
            PG8_LDB(B1, 1, 1); PG8_STAGE(PG8_SB(1, 0), b3, vB2);
            PG8_BAR; PG8_WAIT_L(0); PG8_MMA(0, 1, At, B1); PG8_BAR;
            PG8_LDA(At, 1, 1); PG8_STAGE(PG8_SA(1, 0), a3, vA2);
            PG8_BAR; PG8_WAIT_L(0); PG8_MMA(1, 0, At, B0); PG8_BAR; PG8_SCHED;
            PG8_STAGE(PG8_SB(1, 1), b3 + hstep2, vB2);
            PG8_WAIT_V(6); PG8_BAR; PG8_MMA(1, 1, At, B1); PG8_BAR;
            }
        }
        if constexpr (ALIGN_EPI) { if (wr == 0) PG8_BAR; }
        if constexpr (!Epi::AFTER_DRAIN) { E(acc, cur, wr, wc, fr, fq); S.done(cur); }
        if (!has_next) break;
#pragma unroll
        for (int a = 0; a < 2; ++a)
#pragma unroll
            for (int b = 0; b < 2; ++b)
#pragma unroll
                for (int m = 0; m < 4; ++m)
#pragma unroll
                    for (int n = 0; n < 2; ++n) { acc[a][b][m][n] = (f32x4){0.f, 0.f, 0.f, 0.f}; asm volatile("" : "+v"(acc[a][b][m][n])); }
        cur = nxt; cA = nA; cB = nB; ++ui; voffA[0] = voffAn[0]; voffA[1] = voffAn[1]; voffB[0] = voffBn[0]; voffB[1] = voffBn[1]; hstep = hstepn;
        if constexpr (ALIGN_EPI) { if (wr == 1) PG8_BAR; }
    }
    PG8_WAIT_V(0);
    if constexpr (!ALIGN_EPI) { if (wr == 0) PG8_BAR; }
    PG8_BAR;
    if constexpr (Epi::AFTER_DRAIN) { E.fused(acc, cur, wr, wc, fr, fq, lds, wid, lane); S.done(cur); }
#undef PG8_SA
#undef PG8_SB
#undef PG8_STAGE
#undef PG8_LDA
#undef PG8_LDB
#undef PG8_MMA
#undef PG8_WAIT_V
#undef PG8_WAIT_L
#undef PG8_BAR
#undef PG8_SCHED
}
}

constexpr int NWAVES = 8;
constexpr int D = 1024, MP = 16384, MS = 128, M = 16512, MPAD = 16640, SEQ = 2048, NB = 136, NMOD = 9216;
constexpr int DFF = 2816, NIN = 4352, NSHIFT = 1792, S5W = 512, RWW = 512;
constexpr float NORM_EPS = 1e-6f, GN_EPS = 64e-5f;
enum { I_XP = 0, I_XS, I_CP, I_CS, I_S5RE, I_S5IM, I_WKV, I_SHIFT, I_WADA, I_BADA, I_GFFN1, I_GMIX, I_GFFN2, I_GFINAL,
       I_F1W1, I_F1W3, I_F1W2, I_F2W1, I_F2W3, I_F2W2, I_WIN, I_MU, I_LAMRE, I_LAMIM, I_LOGDT, I_BRE, I_BIM, I_CRE, I_CIM, I_S5D, I_GLUV, I_GLUG,
       I_W0, I_W2, I_A0, I_A2, I_G2, I_KK, I_KA, I_RK, I_LNW, I_LNB, I_PROJ, I_WOUT, N_IN_T };
constexpr size_t O_Y = 0, O_S5RE_P = 16908288, O_S5IM_P = 16924672, O_WKV_P = 16941056, O_SHIFT_P = 17203200,
                 O_S5RE_S = 17217536, O_S5IM_S = 17479680, O_WKV_S = 17741824, O_SHIFT_S = 21936128, O_TOTAL = 22165504;
constexpr size_t MiB = 1u << 20;
constexpr size_t WS_CTL = 0, CTL_ZERO_BYTES = 64 * 1024;
constexpr size_t WS_WADA = 1 * MiB;
constexpr size_t WS_OZ = 1 * MiB;
constexpr size_t WS_Z = WS_OZ;
constexpr int OZP = 1024;
constexpr size_t WS_W13_1 = 19 * MiB;
constexpr size_t WS_W2_1 = 30 * MiB;
constexpr size_t WS_O = WS_OZ + 512 * 2;
constexpr size_t WS_W13_2 = 36 * MiB, WS_W2_2 = 47 * MiB;
constexpr size_t WS_WIN = 53 * MiB;
constexpr size_t WS_GLU = 62 * MiB;
constexpr size_t WS_PROJ = 64 * MiB;
constexpr size_t WS_WOUT = 65 * MiB;
constexpr size_t WS_SC = 67 * MiB;
constexpr size_t WS_LORA = 67 * MiB + 512 * 1024;
constexpr size_t WS_S5PAR = 67 * MiB + 768 * 1024;
constexpr size_t WS_MOD = 68 * MiB;
constexpr size_t WS_SLAB = 246 * MiB;
constexpr size_t WS_GPT = 251 * MiB + 512 * 1024;
constexpr size_t WS_XN = 73 * MiB;
constexpr size_t WS_BIG = 106 * MiB;
constexpr size_t WS_S5IN = WS_BIG, WS_CUR = WS_S5IN + (size_t)MPAD * 512 * 2, WS_GATES = WS_CUR + (size_t)MPAD * 1792 * 2, WS_END = WS_GATES + (size_t)MPAD * 2048 * 2;
static_assert(WS_END <= 256 * MiB, "d_ws map");
static_assert(WS_OZ + (size_t)MPAD * OZP * 2 <= WS_W13_2, "Z | O overlay");

constexpr int RING_BYTES = 131072;
constexpr int MISC_OFF = 159744 - 256;
constexpr int LDS_BYTES = 159744;

#define GAS __attribute__((address_space(1)))
#define LAS __attribute__((address_space(3)))
typedef unsigned short bf16;
typedef unsigned v4u __attribute__((ext_vector_type(4)));
typedef unsigned v2u __attribute__((ext_vector_type(2)));
typedef float f32x4 __attribute__((ext_vector_type(4)));
#define LDS_WAIT() asm volatile("s_waitcnt lgkmcnt(0)" ::: "memory")
#define VM_WAIT() asm volatile("s_waitcnt vmcnt(0)" ::: "memory")
__device__ __forceinline__ unsigned f2bf(float f) { unsigned u = __builtin_bit_cast(unsigned, f); return (u + 0x7fffu + ((u >> 16) & 1u)) >> 16; }
__device__ __forceinline__ unsigned pk2(float lo, float hi) { return pg8::cvt_pk_bf16(lo, hi); }
__device__ __forceinline__ unsigned cvtpk(float lo, float hi) { return pg8::cvt_pk_bf16(lo, hi); }
__device__ __forceinline__ float bf2f(unsigned short h) { return __uint_as_float((unsigned)h << 16); }
__device__ __forceinline__ float bflo(unsigned w) { return __uint_as_float(w << 16); }
__device__ __forceinline__ float bfhi(unsigned w) { return __uint_as_float(w & 0xffff0000u); }
__device__ __forceinline__ float wave_sum(float v) {
#pragma unroll
    for (int o = 1; o < 64; o <<= 1) v += __shfl_xor(v, o);
    return v;
}
__device__ __forceinline__ float sigmoidf_(float x) { return 1.0f / (1.0f + __expf(-x)); }
__device__ __forceinline__ float tanhf_(float x) { const float e = __expf(2.0f * x); return 1.0f - 2.0f / (e + 1.0f); }
__device__ __forceinline__ float gelu_tanh(float y) { const float a = 0.7978845608028654f * (y + 0.044715f * y * y * y); return 0.5f * y * (1.0f + tanhf_(a)); }
__device__ __forceinline__ float softplusf_(float x) { return fmaxf(x, 0.f) + log1pf(__expf(-fabsf(x))); }

struct Args { const float* in[N_IN_T]; float* out; unsigned char* ws; int ph_lo, ph_hi; };
static_assert(sizeof(Args) == N_IN_T * 8 + 8 + 8 + 8, "Args has no padding");
struct Frame {
    LAS unsigned char* lds;
    int tid, lane, wave, G, bid;
    const Args* a;
};

struct TItem { const float* W; bf16* WT; int N, il, ldw, item; };
__device__ __forceinline__ void p0_item_load(const TItem& t, f32x4 (&v)[8], int lane) {
    const int nblk = t.N / 32, kb = t.item / nblk, nb = t.item % nblk;
    const float* p = t.W + (size_t)(64 * kb + (lane >> 3)) * t.N + 32 * nb + 4 * (lane & 7);
#pragma unroll
    for (int i = 0; i < 8; ++i) v[i] = *(const GAS f32x4*)(p + (size_t)(8 * i) * t.N);
}
__device__ __forceinline__ void p0_item_store(const TItem& t, const f32x4 (&v)[8], LAS float* scr, int lane) {
    const int nblk = t.N / 32, kb = t.item / nblk, nb = t.item % nblk, k0 = 64 * kb, n0 = 32 * nb;
    const int r0 = t.il == 0 ? n0 : (256 * (n0 >> 7) + (t.il == 2 ? 128 : 0) + (n0 & 127));
#pragma unroll
    for (int i = 0; i < 8; ++i) { LAS float* s = scr + (8 * i + (lane >> 3)) * 33 + 4 * (lane & 7); s[0] = v[i].x; s[1] = v[i].y; s[2] = v[i].z; s[3] = v[i].w; }
    LDS_WAIT(); asm volatile("" ::: "memory");
    const int c = lane & 7;
#pragma unroll
    for (int j = 0; j < 4; ++j) { const int n = (lane >> 3) + 8 * j; const LAS float* s = scr + (8 * c) * 33 + n;
        v4u o; o.x = pk2(s[0 * 33], s[1 * 33]); o.y = pk2(s[2 * 33], s[3 * 33]); o.z = pk2(s[4 * 33], s[5 * 33]); o.w = pk2(s[6 * 33], s[7 * 33]);
        *(GAS v4u*)(t.WT + (size_t)(r0 + n) * t.ldw + k0 + 8 * c) = o; }
    LDS_WAIT(); asm volatile("" ::: "memory");
}
constexpr int P0_I_ADA = (D / 64) * (NMOD / 32), P0_I_UP = (D / 64) * (DFF / 32), P0_I_DN = (DFF / 64) * (D / 32), P0_I_IN = (D / 64) * (NIN / 32), P0_I_GL = (512 / 64) * (D / 32), P0_I_OUT = (D / 64) * (D / 32);
constexpr int P0_NREST = 4 * P0_I_UP + 2 * P0_I_DN + P0_I_IN + 3 * P0_I_GL + P0_I_OUT + 16 + 16 + 32;
__device__ __forceinline__ TItem p0_item(const Frame& F, int part, int it) {
    unsigned char* ws = F.a->ws;
    if (part == 0) return TItem{F.a->in[I_WADA], (bf16*)(ws + WS_WADA), NMOD, 0, D, it};
    int r = it;
    if (r < P0_I_UP) return TItem{F.a->in[I_F1W1], (bf16*)(ws + WS_W13_1), DFF, 1, D, r}; r -= P0_I_UP;
    if (r < P0_I_UP) return TItem{F.a->in[I_F1W3], (bf16*)(ws + WS_W13_1), DFF, 2, D, r}; r -= P0_I_UP;
    if (r < P0_I_DN) return TItem{F.a->in[I_F1W2], (bf16*)(ws + WS_W2_1), D, 0, DFF, r}; r -= P0_I_DN;
    if (r < P0_I_UP) return TItem{F.a->in[I_F2W1], (bf16*)(ws + WS_W13_2), DFF, 1, D, r}; r -= P0_I_UP;
    if (r < P0_I_UP) return TItem{F.a->in[I_F2W3], (bf16*)(ws + WS_W13_2), DFF, 2, D, r}; r -= P0_I_UP;
    if (r < P0_I_DN) return TItem{F.a->in[I_F2W2], (bf16*)(ws + WS_W2_2), D, 0, DFF, r}; r -= P0_I_DN;
    if (r < P0_I_IN) return TItem{F.a->in[I_WIN], (bf16*)(ws + WS_WIN), NIN, 0, D, r}; r -= P0_I_IN;
    if (r < P0_I_GL) return TItem{F.a->in[I_GLUV], (bf16*)(ws + WS_GPT), D, 1, 1024, r}; r -= P0_I_GL;
    if (r < P0_I_GL) return TItem{F.a->in[I_GLUG], (bf16*)(ws + WS_GPT), D, 2, 1024, r}; r -= P0_I_GL;
    if (r < P0_I_GL) return TItem{F.a->in[I_PROJ], (bf16*)(ws + WS_GPT) + 512, D, 0, 1024, r}; r -= P0_I_GL;
    if (r < P0_I_OUT) return TItem{F.a->in[I_WOUT], (bf16*)(ws + WS_WOUT), D, 0, D, r}; r -= P0_I_OUT;
    if (r < 16) return TItem{F.a->in[I_W2], (bf16*)(ws + WS_LORA), 512, 0, 64, r}; r -= 16;
    if (r < 16) return TItem{F.a->in[I_A2], (bf16*)(ws + WS_LORA) + 512 * 64, 512, 0, 64, r}; r -= 16;
    return TItem{F.a->in[I_G2], (bf16*)(ws + WS_LORA) + 2 * 512 * 64, 512, 0, 128, r};
}
__device__ __forceinline__ void p0_prologue(Frame& F, int part, int wg0) {
    LAS float* scr = (LAS float*)(F.lds + F.wave * 16384);
    if (F.bid >= wg0) {
        const int gw = (F.bid - wg0) * NWAVES + F.wave, NGW = (F.G - wg0) * NWAVES, nit = part == 0 ? P0_I_ADA : P0_NREST;
        if (gw < nit) {
            TItem tn = p0_item(F, part, gw); f32x4 vn[8];
            p0_item_load(tn, vn, F.lane);
            for (int it = gw; it < nit; it += NGW) {
                const TItem t = tn; f32x4 v[8];
#pragma unroll
                for (int i = 0; i < 8; ++i) v[i] = vn[i];
                if (it + NGW < nit) { tn = p0_item(F, part, it + NGW); p0_item_load(tn, vn, F.lane); }
                p0_item_store(t, v, scr, F.lane);
            }
        }
    }
    if (part == 0) {
        bf16* sc = (bf16*)(F.a->ws + WS_SC);
        for (int i = F.bid * 512 + F.tid; i < 256 * D; i += F.G * 512) {
            const int b = i >> 10, k = i & 1023; float v = 0.f;
            if (b < NB) { const float c = b < 8 ? F.a->in[I_CP][b * D + k] : F.a->in[I_CS][(b - 8) * D + k]; v = c * sigmoidf_(c); }
            sc[i] = (bf16)f2bf(v);
        }
    }
}

constexpr int HP = 2048;
template <bool FINAL, bool SRCF32>
__device__ __forceinline__ void norm_phase(Frame& F, const float* src_p, const float* src_s, bf16* hb, const float* g, int sh_idx, int sc_idx, bf16* xn, float* y, const float* slab, int nslab) {
    const int gw = F.bid * NWAVES + F.wave, NGW = F.G * NWAVES;
    const float* mod = (const float*)(F.a->ws + WS_MOD);
    for (int row = gw; row < M; row += NGW) {
        const int c0 = 8 * F.lane;
        f32x4 v[2][2]; float s = 0.f;
        if (SRCF32) {
            const float* xr = row < MP ? src_p + (size_t)row * D : src_s + (size_t)(row - MP) * D;
#pragma unroll
            for (int j = 0; j < 2; ++j) { v[j][0] = *(const GAS f32x4*)(xr + 512 * j + c0); v[j][1] = *(const GAS f32x4*)(xr + 512 * j + c0 + 4); }
        } else {
#pragma unroll
            for (int j = 0; j < 2; ++j) { const v4u h = *(const GAS v4u*)(hb + (size_t)row * HP + 512 * j + c0);
                v[j][0] = (f32x4){bflo(h.x), bfhi(h.x), bflo(h.y), bfhi(h.y)}; v[j][1] = (f32x4){bflo(h.z), bfhi(h.z), bflo(h.w), bfhi(h.w)}; }
        }
        if (row >= MP && nslab > 0) {
            for (int sl = 0; sl < nslab; ++sl) { const float* sv = slab + ((size_t)sl * MS + (row - MP)) * D + c0;
#pragma unroll
                for (int j = 0; j < 2; ++j) { v[j][0] += *(const GAS f32x4*)(sv + 512 * j); v[j][1] += *(const GAS f32x4*)(sv + 512 * j + 4); } }
        }
#pragma unroll
        for (int j = 0; j < 2; ++j)
#pragma unroll
            for (int e = 0; e < 2; ++e) s += (v[j][e].x * v[j][e].x + v[j][e].y * v[j][e].y) + (v[j][e].z * v[j][e].z + v[j][e].w * v[j][e].w);
        const float rstd = 1.0f / sqrtf(wave_sum(s) * (1.0f / D) + NORM_EPS);
        if (FINAL) {
#pragma unroll
            for (int j = 0; j < 2; ++j)
#pragma unroll
                for (int e = 0; e < 2; ++e) { const f32x4 gv = *(const GAS f32x4*)(g + 512 * j + c0 + 4 * e); *(GAS f32x4*)(y + (size_t)row * D + 512 * j + c0 + 4 * e) = v[j][e] * rstd * gv; }
        } else {
            const int b = row < MP ? (row >> 11) : 8 + (row - MP);
            const float* shp = mod + (size_t)b * NMOD + sh_idx * D + c0;
            const float* scp = mod + (size_t)b * NMOD + sc_idx * D + c0;
            if (row >= MP) {
#pragma unroll
                for (int j = 0; j < 2; ++j) *(GAS v4u*)(hb + (size_t)row * HP + 512 * j + c0) = (v4u){pk2(v[j][0].x, v[j][0].y), pk2(v[j][0].z, v[j][0].w), pk2(v[j][1].x, v[j][1].y), pk2(v[j][1].z, v[j][1].w)}; }
#pragma unroll
            for (int j = 0; j < 2; ++j) { f32x4 n[2];
#pragma unroll
                for (int e = 0; e < 2; ++e) { const f32x4 gv = *(const GAS f32x4*)(g + 512 * j + c0 + 4 * e), sh = *(const GAS f32x4*)(shp + 512 * j + 4 * e), sc = *(const GAS f32x4*)(scp + 512 * j + 4 * e);
                    n[e] = (v[j][e] * rstd * gv) * (sc + 1.0f) + sh; }
                *(GAS v4u*)(xn + (size_t)row * D + 512 * j + c0) = (v4u){pk2(n[0].x, n[0].y), pk2(n[0].z, n[0].w), pk2(n[1].x, n[1].y), pk2(n[1].z, n[1].w)}; }
        }
    }
}
#define XB_TMO      128
#define XB_XCNT(j)  (256  + 64 * (j))
#define XB_XSUB(j)  (1280 + 64 * (j))
#define XB_XGEN(j)  (2304 + 64 * (j))
#define XB_TOP      3328
#define XB_TOPGEN   3392
#define XCD_BAR_WORDS 3456
#define XB_SPIN_CAP (1u << 18)

__device__ __forceinline__ unsigned xb_ld(unsigned* p)              { return __hip_atomic_load(p, __ATOMIC_RELAXED, __HIP_MEMORY_SCOPE_AGENT); }
__device__ __forceinline__ unsigned xb_add(unsigned* p, unsigned v) { return __hip_atomic_fetch_add(p, v, __ATOMIC_RELAXED, __HIP_MEMORY_SCOPE_AGENT); }
__device__ __forceinline__ unsigned xb_xcc_id() { return (unsigned)__builtin_amdgcn_s_getreg((3 << 11) | 20) & 0xFu; }
#define XB_SPIN(cond, bar) do { unsigned _sp = 0; while (cond) { __builtin_amdgcn_s_sleep(1); \
    if ((++_sp & 255u) == 0u) { if (xb_ld(&(bar)[XB_TMO])) break; if (_sp > XB_SPIN_CAP) { atomicAdd(&(bar)[XB_TMO], 1u); break; } } } } while (0)

struct XcdBarrier {
    unsigned* bar; unsigned x;
    volatile LAS unsigned* st;
};

__device__ __forceinline__ XcdBarrier xcd_barrier_post(unsigned* bar, volatile LAS unsigned* st) {
    XcdBarrier b; b.bar = bar; b.x = xb_xcc_id(); b.st = st;
    if (threadIdx.x == 0) (void)xb_add(&bar[XB_XCNT(b.x)], 1u);
    return b;
}
__device__ __forceinline__ void xcd_barrier_complete(unsigned* bar, unsigned x, unsigned& nloc, unsigned& nx) {
    const unsigned G = gridDim.x * gridDim.y * gridDim.z;
    unsigned sum, cnt, mine, sp = 0u;
    for (;;) {
        sum = 0u; cnt = 0u; mine = 0u;
#pragma unroll
        for (unsigned j = 0; j < 16; ++j) { const unsigned c = xb_ld(&bar[XB_XCNT(j)]); sum += c; cnt += (c > 0u) ? 1u : 0u; mine = (j == x) ? c : mine; }
        if (sum == G) break;
        __builtin_amdgcn_s_sleep(1);
        if ((++sp & 255u) == 0u) { if (xb_ld(&bar[XB_TMO])) break; if (sp > XB_SPIN_CAP) { atomicAdd(&bar[XB_TMO], 1u); break; } }
    }
    nloc = mine > 0u ? mine : 1u; nx = cnt > 0u ? cnt : 1u;
}

__device__ __forceinline__ void xcd_barrier(const XcdBarrier& b) {
    asm volatile("s_waitcnt vmcnt(0)" ::: "memory");
    __syncthreads();
    if (threadIdx.x == 0) {
        unsigned* bar = b.bar;
        __builtin_amdgcn_s_waitcnt(0);
        unsigned nloc = b.st[0], nx = b.st[1];
        if (nloc == 0u) { xcd_barrier_complete(bar, b.x, nloc, nx); b.st[0] = nloc; b.st[1] = nx; }
        const unsigned old = xb_add(&bar[XB_XSUB(b.x)], 1u);
        const unsigned gen = old / nloc;
        if (old + 1u == (gen + 1u) * nloc) {
            __builtin_amdgcn_fence(__ATOMIC_RELEASE, "agent");
            asm volatile("s_waitcnt vmcnt(0)" ::: "memory");
            const unsigned og = xb_add(&bar[XB_TOP], 1u);
            const unsigned tg = og / nx;
            if (og + 1u == (tg + 1u) * nx) xb_add(&bar[XB_TOPGEN], 1u);
            else XB_SPIN(xb_ld(&bar[XB_TOPGEN]) == tg, bar);
            __builtin_amdgcn_fence(__ATOMIC_ACQUIRE, "agent");
            xb_add(&bar[XB_XGEN(b.x)], 1u);
            asm volatile("s_waitcnt vmcnt(0)" ::: "memory");
        } else {
            XB_SPIN(xb_ld(&bar[XB_XGEN(b.x)]) == gen, bar);
            __builtin_amdgcn_fence(__ATOMIC_ACQUIRE, "agent");
            asm volatile("s_waitcnt vmcnt(0)" ::: "memory");
        }
    }
    __syncthreads();
}

__device__ __forceinline__ void xcd_barrier2(const XcdBarrier& b) {
    asm volatile("s_waitcnt vmcnt(0)" ::: "memory");
    __syncthreads();
    if (threadIdx.x == 0) {
        unsigned* bar = b.bar;
        __builtin_amdgcn_s_waitcnt(0);
        unsigned nloc = b.st[0], nx = b.st[1];
        if (nloc == 0u) { xcd_barrier_complete(bar, b.x, nloc, nx); b.st[0] = nloc; b.st[1] = nx; }
        const unsigned old = xb_add(&bar[XB_XSUB(b.x)], 1u);
        const unsigned gen = old / nloc;
        if (old + 1u == (gen + 1u) * nloc) {
            __builtin_amdgcn_fence(__ATOMIC_RELEASE, "agent");
            asm volatile("s_waitcnt vmcnt(0)" ::: "memory");
            xb_add(&bar[XB_TOP], 1u);
        }
        const unsigned want = (gen + 1u) * nx;
        XB_SPIN(xb_ld(&bar[XB_TOP]) < want, bar);
        __builtin_amdgcn_fence(__ATOMIC_ACQUIRE, "agent");
        asm volatile("s_waitcnt vmcnt(0)" ::: "memory");
    }
    __syncthreads();
}

__device__ __forceinline__ void xcd_barrier3(const XcdBarrier& b) {
    asm volatile("s_waitcnt vmcnt(0)" ::: "memory");
    __syncthreads();
    if (threadIdx.x == 0) {
        unsigned* bar = b.bar;
        __builtin_amdgcn_s_waitcnt(0);
        unsigned nloc = b.st[0], nx = b.st[1];
        if (nloc == 0u) { xcd_barrier_complete(bar, b.x, nloc, nx); b.st[0] = nloc; b.st[1] = nx; }
        const unsigned old = xb_add(&bar[XB_XSUB(b.x)], 1u);
        asm volatile("buffer_inv sc1" ::: "memory");
        const unsigned gen = old / nloc;
        if (old + 1u == (gen + 1u) * nloc) {
            __builtin_amdgcn_fence(__ATOMIC_RELEASE, "agent");
            asm volatile("s_waitcnt vmcnt(0)" ::: "memory");
            xb_add(&bar[XB_TOP], 1u);
        }
        const unsigned want = (gen + 1u) * nx;
        XB_SPIN(xb_ld(&bar[XB_TOP]) < want, bar);
        asm volatile("s_waitcnt vmcnt(0)" ::: "memory");
    }
    __syncthreads();
}

__device__ __forceinline__ void flat_barrier(const XcdBarrier& b) {
    asm volatile("s_waitcnt vmcnt(0)" ::: "memory");
    __syncthreads();
    if (threadIdx.x == 0) {
        unsigned* bar = b.bar;
        __builtin_amdgcn_s_waitcnt(0);
        const unsigned epoch = b.st[2]; b.st[2] = epoch + 1u;
        __builtin_amdgcn_fence(__ATOMIC_RELEASE, "agent");
        asm volatile("s_waitcnt vmcnt(0)" ::: "memory");
        xb_add(&bar[XB_TOP], 1u);
        const unsigned want = (epoch + 1u) * (gridDim.x * gridDim.y * gridDim.z);
        XB_SPIN(xb_ld(&bar[XB_TOP]) < want, bar);
        __builtin_amdgcn_fence(__ATOMIC_ACQUIRE, "agent");
        asm volatile("s_waitcnt vmcnt(0)" ::: "memory");
    }
    __syncthreads();
}

typedef short bf16x8 __attribute__((ext_vector_type(8)));
__device__ __forceinline__ f32x4 mfma_safe(bf16x8 a, bf16x8 b, f32x4 c, int, int, int) {
    const f32x4 d = __builtin_amdgcn_mfma_f32_16x16x32_bf16(a, b, c, 0, 0, 0);
    asm volatile("" :: "v"(d), "v"(a), "v"(b));
    return d;
}
constexpr int RL = 72, RSLOT = 64 * RL * 2;
constexpr int RX_OFF = 16 * RSLOT;
static_assert(RX_OFF + 3 * 1024 <= MISC_OFF, "rwkv2 LDS");
enum { SL_AT = 0, SL_BB = 1, SL_KB = 2, SL_N = 3, SL_NT = 4, SL_MAK = 5, SL_RT = 6, SL_ATT = 7, SL_VT = 8, SL_BHT = 9, SL_KHT = 10, SL_MRB = 11, SL_MRK = 12, SL_RHS = 13, SL_T0 = 14, SL_SB = 15,
       SL_PA = 0, SL_PTA = 1, SL_PB = 2, SL_PTB = 3, SL_T1 = 4, SL_W = 5, SL_UT = 14, SL_WD = 3, SL_AD = 4, SL_GD = 11 };
#define RSL(s) ((LAS bf16*)(F.lds + (s) * RSLOT))
__device__ __forceinline__ bf16x8 ldfrag(const LAS bf16* Mx, int row0, int k0, int lane) { return *(const LAS bf16x8*)(Mx + (row0 + (lane & 15)) * RL + k0 + 8 * (lane >> 4)); }
template <int KS>
__device__ __forceinline__ void mm2(f32x4 (&acc)[2], const LAS bf16* P, const LAS bf16* Q, int p0, int q0, int lane) {
#pragma unroll
    for (int ks = 0; ks < KS; ++ks) {
        const bf16x8 pf = ldfrag(P, p0, 32 * ks, lane), q0f = ldfrag(Q, q0, 32 * ks, lane), q1f = ldfrag(Q, q0 + 16, 32 * ks, lane);
        acc[0] = mfma_safe(q0f, pf, acc[0], 0, 0, 0);
        acc[1] = mfma_safe(q1f, pf, acc[1], 0, 0, 0);
    }
#ifdef MM2_FENCE
    asm volatile("s_nop 15" : "+v"(acc[0]), "+v"(acc[1]));
#endif
}
__device__ __forceinline__ void st_pq(LAS bf16* O, const f32x4 (&v)[2], int p0, int q0, int lane) {
#pragma unroll
    for (int tl = 0; tl < 2; ++tl) *(LAS v2u*)(O + (p0 + (lane & 15)) * RL + q0 + 16 * tl + 4 * (lane >> 4)) = (v2u){pk2(v[tl][0], v[tl][1]), pk2(v[tl][2], v[tl][3])};
}
__device__ __forceinline__ void st_qp(LAS bf16* O, const f32x4 (&v)[2], int p0, int q0, int lane) {
#pragma unroll
    for (int tl = 0; tl < 2; ++tl)
#pragma unroll
        for (int r = 0; r < 4; ++r) O[(q0 + 16 * tl + 4 * (lane >> 4) + r) * RL + p0 + (lane & 15)] = (bf16)f2bf(v[tl][r]);
}
#define RW_BAR() do { asm volatile("s_waitcnt lgkmcnt(0)" ::: "memory"); __builtin_amdgcn_s_barrier(); asm volatile("" ::: "memory"); } while (0)

__device__ __forceinline__ void rwkv_prompt_unit2(Frame& F, int b, int h) {
    const int lane_ = F.lane, w = F.wave;
    const int p0 = 16 * (w >> 1), q0 = 32 * (w & 1);
    const bf16* cur = (const bf16*)(F.a->ws + WS_CUR); bf16* O = (bf16*)(F.a->ws + WS_O);
    const bf16* W2T = (const bf16*)(F.a->ws + WS_LORA); const bf16* A2T = W2T + 512 * 64; const bf16* G2T = A2T + 512 * 64;
    const float* mu = F.a->in[I_MU];
    LAS float* XCH = (LAS float*)(F.lds + RX_OFF); LAS float* LT = XCH + 256; LAS float* XCH2 = LT + 256;
    f32x4 Sreg[2] = {{0.f, 0.f, 0.f, 0.f}, {0.f, 0.f, 0.f, 0.f}};
    { const f32x4 z[2] = {{0.f, 0.f, 0.f, 0.f}, {0.f, 0.f, 0.f, 0.f}}; st_pq(RSL(SL_SB), z, p0, q0, lane_); }
#pragma unroll 1
    for (int ch = 0; ch < SEQ / 64; ++ch) {
        int lane = lane_, tid = F.tid; asm volatile("" : "+v"(lane), "+v"(tid));
        const int li = lane & 15, lq = lane >> 4;
        const size_t row0 = (size_t)b * SEQ + ch * 64;
#pragma unroll
        for (int it = 0; it < 4; ++it) {
            const int item = it * 512 + tid, t = item >> 5, vi = item & 31, col = 1536 + 8 * vi;
            const size_t row = row0 + t;
            const v4u c = *(const GAS v4u*)(cur + row * NSHIFT + col);
            v4u p = (v4u){0u, 0u, 0u, 0u};
            if (ch + t > 0) p = *(const GAS v4u*)(cur + (row - 1) * NSHIFT + col);
            const f32x4 m0 = *(const GAS f32x4*)(mu + col), m1 = *(const GAS f32x4*)(mu + col + 4);
            float x[8];
            { const float c0 = bflo(c.x), c1 = bfhi(c.x), c2 = bflo(c.y), c3 = bfhi(c.y), c4 = bflo(c.z), c5 = bfhi(c.z), c6 = bflo(c.w), c7 = bfhi(c.w);
              x[0] = c0 + m0.x * (bflo(p.x) - c0); x[1] = c1 + m0.y * (bfhi(p.x) - c1); x[2] = c2 + m0.z * (bflo(p.y) - c2); x[3] = c3 + m0.w * (bfhi(p.y) - c3);
              x[4] = c4 + m1.x * (bflo(p.z) - c4); x[5] = c5 + m1.y * (bfhi(p.z) - c5); x[6] = c6 + m1.z * (bflo(p.w) - c6); x[7] = c7 + m1.w * (bfhi(p.w) - c7); }
            if (vi < 8) {
#pragma unroll
                for (int i = 0; i < 8; ++i) x[i] = tanhf_(x[i]);
                *(LAS v4u*)(RSL(SL_WD) + t * RL + 8 * vi) = (v4u){pk2(x[0], x[1]), pk2(x[2], x[3]), pk2(x[4], x[5]), pk2(x[6], x[7])};
            } else if (vi < 16) {
                *(LAS v4u*)(RSL(SL_AD) + t * RL + 8 * (vi - 8)) = (v4u){pk2(x[0], x[1]), pk2(x[2], x[3]), pk2(x[4], x[5]), pk2(x[6], x[7])};
            } else {
#pragma unroll
                for (int i = 0; i < 8; ++i) x[i] = sigmoidf_(x[i]);
                *(LAS v4u*)(RSL(SL_GD) + t * 136 + 8 * (vi - 16)) = (v4u){pk2(x[0], x[1]), pk2(x[2], x[3]), pk2(x[4], x[5]), pk2(x[6], x[7])};
            }
        }
        f32x4 rr[2], kr[2], vr[2];
        {
            const size_t row = row0 + p0 + li; const bool hasprev = (ch + p0 + li) > 0;
#pragma unroll
            for (int tl = 0; tl < 2; ++tl) {
                const int jc = 64 * h + q0 + 16 * tl + 4 * lq;
#pragma unroll
                for (int s = 0; s < 3; ++s) {
                    const int col = 512 * s + jc;
                    const v2u c = *(const GAS v2u*)(cur + row * NSHIFT + col);
                    v2u p = (v2u){0u, 0u};
                    if (hasprev) p = *(const GAS v2u*)(cur + (row - 1) * NSHIFT + col);
                    const f32x4 m = *(const GAS f32x4*)(mu + col);
                    const float c0 = bflo(c.x), c1 = bfhi(c.x), c2 = bflo(c.y), c3 = bfhi(c.y);
                    const f32x4 x = (f32x4){c0 + m.x * (bflo(p.x) - c0), c1 + m.y * (bfhi(p.x) - c1), c2 + m.z * (bflo(p.y) - c2), c3 + m.w * (bfhi(p.y) - c3)};
                    if (s == 0) rr[tl] = x; else if (s == 1) kr[tl] = x; else vr[tl] = x;
                }
            }
        }
        RW_BAR();
        f32x4 aw[2], aa[2], ag[2] = {{0.f, 0.f, 0.f, 0.f}, {0.f, 0.f, 0.f, 0.f}};
#pragma unroll
        for (int tl = 0; tl < 2; ++tl) { const int jc = 64 * h + q0 + 16 * tl + 4 * lq; aw[tl] = *(const GAS f32x4*)(F.a->in[I_W0] + jc); aa[tl] = *(const GAS f32x4*)(F.a->in[I_A0] + jc); }
        {
#pragma unroll
            for (int ks = 0; ks < 2; ++ks) {
                const bf16x8 pw = ldfrag(RSL(SL_WD), p0, 32 * ks, lane), pa = ldfrag(RSL(SL_AD), p0, 32 * ks, lane);
#pragma unroll
                for (int tl = 0; tl < 2; ++tl) {
                    const size_t wr = (size_t)(64 * h + q0 + 16 * tl + li) * 64 + 32 * ks + 8 * lq;
                    const bf16x8 qw = *(const GAS bf16x8*)(W2T + wr), qa = *(const GAS bf16x8*)(A2T + wr);
                    aw[tl] = mfma_safe(qw, pw, aw[tl], 0, 0, 0);
                    aa[tl] = mfma_safe(qa, pa, aa[tl], 0, 0, 0);
                }
            }
#pragma unroll
            for (int ks = 0; ks < 4; ++ks) {
                const bf16x8 pg = *(const LAS bf16x8*)(RSL(SL_GD) + (p0 + li) * 136 + 32 * ks + 8 * lq);
#pragma unroll
                for (int tl = 0; tl < 2; ++tl) {
                    const bf16x8 qg = *(const GAS bf16x8*)(G2T + (size_t)(64 * h + q0 + 16 * tl + li) * 128 + 32 * ks + 8 * lq);
                    ag[tl] = mfma_safe(qg, pg, ag[tl], 0, 0, 0);
                }
            }
        }
        f32x4 ldv[2], alv[2], kkv[2], kpv[2], Lc[2];
        float ss = 0.f, bon = 0.f;
#pragma unroll
        for (int tl = 0; tl < 2; ++tl) {
            const int jc = 64 * h + q0 + 16 * tl + 4 * lq;
            const f32x4 c_kk = *(const GAS f32x4*)(F.a->in[I_KK] + jc), c_ka = *(const GAS f32x4*)(F.a->in[I_KA] + jc), c_rk = *(const GAS f32x4*)(F.a->in[I_RK] + jc);
#pragma unroll
            for (int r = 0; r < 4; ++r) {
                const float wv = -softplusf_(-aw[tl][r]) - 0.5f;
                ldv[tl][r] = -__expf(wv);
                alv[tl][r] = sigmoidf_(aa[tl][r]);
                kkv[tl][r] = kr[tl][r] * c_kk[r]; ss += kkv[tl][r] * kkv[tl][r];
                kpv[tl][r] = kr[tl][r] * (1.0f + (alv[tl][r] - 1.0f) * c_ka[r]);
                bon += rr[tl][r] * kpv[tl][r] * c_rk[r];
                float x = ldv[tl][r];
#pragma unroll
                for (int o = 1; o < 16; o <<= 1) { const float y = __shfl_up(x, o, 16); if (li >= o) x += y; }
                Lc[tl][r] = x;
            }
        }
        ss += __shfl_xor(ss, 16); ss += __shfl_xor(ss, 32); bon += __shfl_xor(bon, 16); bon += __shfl_xor(bon, 32);
        if (lane < 16) { XCH[(w * 16 + li) * 2] = ss; XCH[(w * 16 + li) * 2 + 1] = bon; }
        if (li == 15) {
#pragma unroll
            for (int tl = 0; tl < 2; ++tl) *(LAS f32x4*)(LT + (w >> 1) * 64 + q0 + 16 * tl + 4 * lq) = Lc[tl];
        }
        RW_BAR();
        {
            const int wp = w ^ 1; ss += XCH[(wp * 16 + li) * 2]; bon += XCH[(wp * 16 + li) * 2 + 1];
        }
        const float inv = 1.0f / fmaxf(sqrtf(ss), 1e-12f);
        f32x4 gC[2];
#pragma unroll
        for (int tl = 0; tl < 2; ++tl) {
            const int jq = q0 + 16 * tl + 4 * lq;
            f32x4 off = {0.f, 0.f, 0.f, 0.f}, tot = {0.f, 0.f, 0.f, 0.f};
#pragma unroll
            for (int pb = 0; pb < 4; ++pb) { const f32x4 x = *(const LAS f32x4*)(LT + pb * 64 + jq); tot += x; if (pb < (w >> 1)) off += x; }
            f32x4 at, rt, bb, kb, bh, kh;
#pragma unroll
            for (int r = 0; r < 4; ++r) {
                const float Lt = Lc[tl][r] + off[r], gt = __expf(Lt), gp = __expf(Lt - ldv[tl][r]), gi = __expf(-Lt), gh = __expf(tot[r] - Lt);
                gC[tl][r] = __expf(tot[r]);
                const float kn = kkv[tl][r] * inv, bv = kn * alv[tl][r];
                at[r] = -kn * gp; rt[r] = rr[tl][r] * gt; bb[r] = bv * gi; kb[r] = kpv[tl][r] * gi; bh[r] = bv * gh; kh[r] = kpv[tl][r] * gh;
            }
            const int ro = (p0 + li) * RL + jq;
            *(LAS v2u*)(RSL(SL_AT) + ro) = (v2u){pk2(at[0], at[1]), pk2(at[2], at[3])};
            *(LAS v2u*)(RSL(SL_RT) + ro) = (v2u){pk2(rt[0], rt[1]), pk2(rt[2], rt[3])};
            *(LAS v2u*)(RSL(SL_BB) + ro) = (v2u){pk2(bb[0], bb[1]), pk2(bb[2], bb[3])};
            *(LAS v2u*)(RSL(SL_KB) + ro) = (v2u){pk2(kb[0], kb[1]), pk2(kb[2], kb[3])};
#pragma unroll
            for (int r = 0; r < 4; ++r) { const int co = (jq + r) * RL + p0 + li;
                RSL(SL_ATT)[co] = (bf16)f2bf(at[r]); RSL(SL_BHT)[co] = (bf16)f2bf(bh[r]); RSL(SL_KHT)[co] = (bf16)f2bf(kh[r]); RSL(SL_VT)[co] = (bf16)f2bf(vr[tl][r]); }
        }
        RW_BAR();
        f32x4 Treg[2];
        {
            f32x4 n_[2] = {{0.f, 0.f, 0.f, 0.f}, {0.f, 0.f, 0.f, 0.f}}, mak[2] = {{0.f, 0.f, 0.f, 0.f}, {0.f, 0.f, 0.f, 0.f}}, mrb[2] = {{0.f, 0.f, 0.f, 0.f}, {0.f, 0.f, 0.f, 0.f}}, mrk[2] = {{0.f, 0.f, 0.f, 0.f}, {0.f, 0.f, 0.f, 0.f}};
            mm2<2>(n_, RSL(SL_AT), RSL(SL_BB), p0, q0, lane); mm2<2>(mak, RSL(SL_AT), RSL(SL_KB), p0, q0, lane);
            mm2<2>(mrb, RSL(SL_RT), RSL(SL_BB), p0, q0, lane); mm2<2>(mrk, RSL(SL_RT), RSL(SL_KB), p0, q0, lane);
#pragma unroll
            for (int tl = 0; tl < 2; ++tl)
#pragma unroll
                for (int r = 0; r < 4; ++r) { const int t = p0 + li, s = q0 + 16 * tl + 4 * lq + r;
                    if (!(t > s)) { n_[tl][r] = 0.f; mak[tl][r] = 0.f; } if (!(t >= s)) { mrb[tl][r] = 0.f; mrk[tl][r] = 0.f; }
                    Treg[tl][r] = n_[tl][r] + (t == s ? 1.0f : 0.0f); }
            st_pq(RSL(SL_N), n_, p0, q0, lane); st_qp(RSL(SL_NT), n_, p0, q0, lane); st_pq(RSL(SL_MAK), mak, p0, q0, lane);
            st_pq(RSL(SL_MRB), mrb, p0, q0, lane); st_pq(RSL(SL_MRK), mrk, p0, q0, lane); st_pq(RSL(SL_T0), Treg, p0, q0, lane);
        }
        RW_BAR();
        {
            f32x4 pa[2] = {{0.f, 0.f, 0.f, 0.f}, {0.f, 0.f, 0.f, 0.f}}, rh[2] = {{0.f, 0.f, 0.f, 0.f}, {0.f, 0.f, 0.f, 0.f}};
            mm2<2>(pa, RSL(SL_N), RSL(SL_NT), p0, q0, lane); mm2<2>(rh, RSL(SL_VT), RSL(SL_MAK), p0, q0, lane);
            st_pq(RSL(SL_PA), pa, p0, q0, lane); st_qp(RSL(SL_PTA), pa, p0, q0, lane); st_pq(RSL(SL_RHS), rh, p0, q0, lane);
        }
        RW_BAR();
        {
            f32x4 pb[2] = {{0.f, 0.f, 0.f, 0.f}, {0.f, 0.f, 0.f, 0.f}};
            mm2<2>(Treg, RSL(SL_T0), RSL(SL_PTA), p0, q0, lane); mm2<2>(pb, RSL(SL_PA), RSL(SL_PTA), p0, q0, lane);
            st_pq(RSL(SL_T1), Treg, p0, q0, lane); st_pq(RSL(SL_PB), pb, p0, q0, lane); st_qp(RSL(SL_PTB), pb, p0, q0, lane);
        }
        RW_BAR();
        {
            f32x4 pa[2] = {{0.f, 0.f, 0.f, 0.f}, {0.f, 0.f, 0.f, 0.f}};
            mm2<2>(Treg, RSL(SL_T1), RSL(SL_PTB), p0, q0, lane); mm2<2>(pa, RSL(SL_PB), RSL(SL_PTB), p0, q0, lane);
            st_pq(RSL(SL_T0), Treg, p0, q0, lane); st_pq(RSL(SL_PA), pa, p0, q0, lane); st_qp(RSL(SL_PTA), pa, p0, q0, lane);
        }
        RW_BAR();
        {
            f32x4 pb[2] = {{0.f, 0.f, 0.f, 0.f}, {0.f, 0.f, 0.f, 0.f}};
            mm2<2>(Treg, RSL(SL_T0), RSL(SL_PTA), p0, q0, lane); mm2<2>(pb, RSL(SL_PA), RSL(SL_PTA), p0, q0, lane);
            st_pq(RSL(SL_T1), Treg, p0, q0, lane); st_pq(RSL(SL_PB), pb, p0, q0, lane); st_qp(RSL(SL_PTB), pb, p0, q0, lane);
        }
        RW_BAR();
        {
            f32x4 pt[2] = {{0.f, 0.f, 0.f, 0.f}, {0.f, 0.f, 0.f, 0.f}};
            mm2<2>(Treg, RSL(SL_T1), RSL(SL_PTB), p0, q0, lane); mm2<2>(pt, RSL(SL_PTB), RSL(SL_PB), p0, q0, lane);
            st_pq(RSL(SL_T0), Treg, p0, q0, lane); st_pq(RSL(SL_PTA), pt, p0, q0, lane);
        }
        RW_BAR();
        {
            mm2<2>(Treg, RSL(SL_T0), RSL(SL_PTA), p0, q0, lane);
            st_pq(RSL(SL_T1), Treg, p0, q0, lane);
        }
        RW_BAR();
        {
            f32x4 wv[2] = {{0.f, 0.f, 0.f, 0.f}, {0.f, 0.f, 0.f, 0.f}};
            mm2<2>(wv, RSL(SL_T1), RSL(SL_ATT), p0, q0, lane);
            st_pq(RSL(SL_W), wv, p0, q0, lane);
        }
        RW_BAR();
        f32x4 Yreg[2] = {{0.f, 0.f, 0.f, 0.f}, {0.f, 0.f, 0.f, 0.f}};
        {
            f32x4 ut[2] = {{0.f, 0.f, 0.f, 0.f}, {0.f, 0.f, 0.f, 0.f}};
            mm2<2>(ut, RSL(SL_SB), RSL(SL_W), p0, q0, lane); mm2<2>(ut, RSL(SL_RHS), RSL(SL_T1), p0, q0, lane);
            mm2<2>(Yreg, RSL(SL_RT), RSL(SL_SB), p0, q0, lane);
            st_pq(RSL(SL_UT), ut, p0, q0, lane);
        }
        RW_BAR();
        {
#pragma unroll
            for (int tl = 0; tl < 2; ++tl) Sreg[tl] = Sreg[tl] * gC[tl];
            mm2<2>(Sreg, RSL(SL_UT), RSL(SL_BHT), p0, q0, lane); mm2<2>(Sreg, RSL(SL_VT), RSL(SL_KHT), p0, q0, lane);
            mm2<2>(Yreg, RSL(SL_MRB), RSL(SL_UT), p0, q0, lane); mm2<2>(Yreg, RSL(SL_MRK), RSL(SL_VT), p0, q0, lane);
            st_pq(RSL(SL_SB), Sreg, p0, q0, lane);
        }
        {
            float s = 0.f;
#pragma unroll
            for (int tl = 0; tl < 2; ++tl) s += (Yreg[tl][0] + Yreg[tl][1]) + (Yreg[tl][2] + Yreg[tl][3]);
            s += __shfl_xor(s, 16); s += __shfl_xor(s, 32);
            const float mw = s * (1.0f / 32.0f); float q = 0.f;
#pragma unroll
            for (int tl = 0; tl < 2; ++tl)
#pragma unroll
                for (int r = 0; r < 4; ++r) { const float d = Yreg[tl][r] - mw; q += d * d; }
            q += __shfl_xor(q, 16); q += __shfl_xor(q, 32);
            if (lane < 16) { XCH2[(w * 16 + li) * 2] = mw; XCH2[(w * 16 + li) * 2 + 1] = q; }
            RW_BAR();
            const float mo = XCH2[((w ^ 1) * 16 + li) * 2], qo = XCH2[((w ^ 1) * 16 + li) * 2 + 1];
            const float mean = 0.5f * (mw + mo), dm = mw - mo, m2 = q + qo + 16.0f * dm * dm;
            const float rstd = 1.0f / sqrtf(m2 * (1.0f / 64.0f) + GN_EPS);
#pragma unroll
            for (int tl = 0; tl < 2; ++tl) {
                const int jc = 64 * h + q0 + 16 * tl + 4 * lq;
                const f32x4 c_lnw = *(const GAS f32x4*)(F.a->in[I_LNW] + jc), c_lnb = *(const GAS f32x4*)(F.a->in[I_LNB] + jc);
                float o[4];
#pragma unroll
                for (int r = 0; r < 4; ++r) o[r] = ((Yreg[tl][r] - mean) * rstd * c_lnw[r] + c_lnb[r] + bon * vr[tl][r]) * ag[tl][r];
                *(GAS v2u*)(O + (row0 + p0 + li) * 512 + 64 * h + q0 + 16 * tl + 4 * lq) = (v2u){pk2(o[0], o[1]), pk2(o[2], o[3])};
            }
        }
        RW_BAR();
    }
    {
        const int li = lane_ & 15, lq = lane_ >> 4;
        float* so = F.a->out + O_WKV_P + ((size_t)(b * 8 + h) * 64 + p0 + li) * 64 + q0 + 4 * lq;
#pragma unroll
        for (int tl = 0; tl < 2; ++tl) *(GAS f32x4*)(so + 16 * tl) = Sreg[tl];
    }
}

__device__ __forceinline__ void s5_par_prologue(Frame& F) {
    float* par = (float*)(F.a->ws + WS_S5PAR);
    for (int i = F.bid * 512 + F.tid; i < 2048; i += F.G * 512) {
        const int g = i >> 6;
        const double dt = exp((double)F.a->in[I_LOGDT][g]);
        const double lr = (double)F.a->in[I_LAMRE][i], li = (double)F.a->in[I_LAMIM][i];
        const double mag = exp(lr * dt), ang = li * dt;
        const double lbr = mag * cos(ang), lbi = mag * sin(ang);
        const double den = lr * lr + li * li, numr = lbr - 1.0;
        const double kr = (numr * lr + lbi * li) / den, ki = (lbi * lr - numr * li) / den;
        double pr = lbr, pi = lbi;
#pragma unroll
        for (int s = 0; s < 8; ++s) { const double t = pr * pr - pi * pi; pi = 2.0 * pr * pi; pr = t; }
        *(GAS f32x4*)(par + i * 8) = (f32x4){(float)lbr, (float)lbi, (float)kr, (float)ki};
        *(GAS f32x4*)(par + i * 8 + 4) = (f32x4){(float)pr, (float)pi, 0.f, 0.f};
    }
}
constexpr int S5_BT = 20, S5_XS = 136;
constexpr int S5_WAVE_BYTES = 128 * S5_BT * 4 + 16 * S5_XS * 2;
static_assert(4096 + 8 * S5_WAVE_BYTES <= MISC_OFF, "s5 LDS");
__device__ __forceinline__ void s5_prompt_unit2(Frame& F, int b, int g) {
    const int lane = F.lane, w = F.wave, li = lane & 15, lq = lane >> 4;
    LAS float* ERE = (LAS float*)F.lds;
    LAS float* EIM = ERE + 512;
    LAS float* BUT = (LAS float*)(F.lds + 4096 + w * S5_WAVE_BYTES);
    LAS bf16* X = (LAS bf16*)(BUT + 128 * S5_BT);
    const bf16* s5in = (const bf16*)(F.a->ws + WS_S5IN); bf16* Z = (bf16*)(F.a->ws + WS_Z);
    const float* par = (const float*)(F.a->ws + WS_S5PAR) + (size_t)g * 64 * 8;
    bf16x8 bfr[8];
#pragma unroll
    for (int k = 0; k < 4; ++k) {
        const int n = 16 * k + li;
        const f32x4 pn = *(const GAS f32x4*)(par + n * 8);
        float re[8], im[8];
        if (lq < 2) {
            const float* br = F.a->in[I_BRE] + (size_t)(g * 64 + n) * 16 + 8 * lq; const float* bi = F.a->in[I_BIM] + (size_t)(g * 64 + n) * 16 + 8 * lq;
#pragma unroll
            for (int j = 0; j < 8; ++j) { const float x = br[j], y = bi[j]; re[j] = pn.z * x - pn.w * y; im[j] = pn.z * y + pn.w * x; }
        } else {
#pragma unroll
            for (int j = 0; j < 8; ++j) { re[j] = 0.f; im[j] = 0.f; }
        }
        const v4u r4 = (v4u){cvtpk(re[0], re[1]), cvtpk(re[2], re[3]), cvtpk(re[4], re[5]), cvtpk(re[6], re[7])};
        const v4u i4 = (v4u){cvtpk(im[0], im[1]), cvtpk(im[2], im[3]), cvtpk(im[4], im[5]), cvtpk(im[6], im[7])};
        bfr[k] = __builtin_bit_cast(bf16x8, r4); bfr[k + 4] = __builtin_bit_cast(bf16x8, i4);
    }
    bf16x8 cfr[4];
#pragma unroll
    for (int ks = 0; ks < 4; ++ks) {
        const int n0 = 16 * ks + 4 * lq;
        const f32x4 cr = *(const GAS f32x4*)(F.a->in[I_CRE] + (size_t)(g * 16 + li) * 64 + n0), ci = *(const GAS f32x4*)(F.a->in[I_CIM] + (size_t)(g * 16 + li) * 64 + n0);
        const v4u c4 = (v4u){cvtpk(cr.x, -ci.x), cvtpk(cr.y, -ci.y), cvtpk(cr.z, -ci.z), cvtpk(cr.w, -ci.w)};
        cfr[ks] = __builtin_bit_cast(bf16x8, c4);
    }
    const f32x4 pl = *(const GAS f32x4*)(par + lane * 8);
    const float lbr = pl.x, lbi = pl.y;
    const f32x4 dco = *(const GAS f32x4*)(F.a->in[I_S5D] + 16 * g + 4 * lq);
    const size_t rowbase = (size_t)b * SEQ + 256 * w;
    float xr = 0.f, xi = 0.f;
#pragma unroll 1
    for (int pass = 0; pass < 2; ++pass) {
        v4u un = (v4u){0u, 0u, 0u, 0u};
        if (lq < 2) un = *(const GAS v4u*)(s5in + (rowbase + li) * 512 + 16 * g + 8 * lq);
        v2u uun = *(const GAS v2u*)(s5in + (rowbase + li) * 512 + 16 * g + 4 * lq);
#pragma unroll 1
        for (int blk = 0; blk < 16; ++blk) {
            const v4u ua = un;
            if (lq < 2 && blk < 15) un = *(const GAS v4u*)(s5in + (rowbase + (blk + 1) * 16 + li) * 512 + 16 * g + 8 * lq);
            const v2u uu = uun;
            uun = *(const GAS v2u*)(s5in + (rowbase + (blk < 15 ? blk + 1 : 15) * 16 + li) * 512 + 16 * g + 4 * lq);
            const bf16x8 uf = __builtin_bit_cast(bf16x8, ua);
            f32x4 dd[8];
#pragma unroll
            for (int k = 0; k < 8; ++k) { dd[k] = (f32x4){0.f, 0.f, 0.f, 0.f}; asm volatile("" : "+v"(dd[k])); dd[k] = mfma_safe(uf, bfr[k], dd[k], 0, 0, 0); }
            asm volatile("s_nop 15\n\ts_nop 15" : "+v"(dd[0]), "+v"(dd[1]), "+v"(dd[2]), "+v"(dd[3]), "+v"(dd[4]), "+v"(dd[5]), "+v"(dd[6]), "+v"(dd[7]) : "v"(ua));
#pragma unroll
            for (int k = 0; k < 8; ++k) *(LAS f32x4*)(BUT + (16 * k + li) * S5_BT + 4 * lq) = dd[k];
            LDS_WAIT();
            f32x4 br_[4], bi_[4];
#pragma unroll
            for (int j = 0; j < 4; ++j) { br_[j] = *(const LAS f32x4*)(BUT + lane * S5_BT + 4 * j); bi_[j] = *(const LAS f32x4*)(BUT + (64 + lane) * S5_BT + 4 * j); }
            if (pass == 0) {
#pragma unroll
                for (int t = 0; t < 16; ++t) { const float bur = br_[t >> 2][t & 3], bui = bi_[t >> 2][t & 3];
                    const float nr = lbr * xr - lbi * xi + bur, ni = lbr * xi + lbi * xr + bui; xr = nr; xi = ni; }
            } else {
#pragma unroll
                for (int t = 0; t < 16; ++t) { const float bur = br_[t >> 2][t & 3], bui = bi_[t >> 2][t & 3];
                    const float nr = lbr * xr - lbi * xi + bur, ni = lbr * xi + lbi * xr + bui; xr = nr; xi = ni;
                    *(LAS unsigned*)(X + t * S5_XS + 2 * lane) = cvtpk(xr, xi); }
                LDS_WAIT();
                f32x4 y = {0.f, 0.f, 0.f, 0.f}; asm volatile("" : "+v"(y));
#pragma unroll
                for (int ks = 0; ks < 4; ++ks) { const bf16x8 xf = *(const LAS bf16x8*)(X + li * S5_XS + 32 * ks + 8 * lq);
                    y = mfma_safe(cfr[ks], xf, y, 0, 0, 0); }
                const size_t roz = (rowbase + blk * 16 + li) * OZP + 16 * g + 4 * lq;
                const float z0 = gelu_tanh(y[0] + dco.x * bflo(uu.x)), z1 = gelu_tanh(y[1] + dco.y * bfhi(uu.x)), z2 = gelu_tanh(y[2] + dco.z * bflo(uu.y)), z3 = gelu_tanh(y[3] + dco.w * bfhi(uu.y));
                *(GAS v2u*)(Z + roz) = (v2u){cvtpk(z0, z1), cvtpk(z2, z3)};
            }
            LDS_WAIT();
        }
        if (pass == 0) {
            ERE[w * 64 + lane] = xr; EIM[w * 64 + lane] = xi;
            __syncthreads();
            const f32x4 p2 = *(const GAS f32x4*)(par + lane * 8 + 4);
            float cr = 0.f, ci = 0.f;
            for (int ww = 0; ww < w; ++ww) { const float er = ERE[ww * 64 + lane], ei = EIM[ww * 64 + lane]; const float t = p2.x * cr - p2.y * ci + er; ci = p2.x * ci + p2.y * cr + ei; cr = t; }
            xr = cr; xi = ci;
        }
    }
    if (w == 7) { F.a->out[O_S5RE_P + (size_t)(b * 32 + g) * 64 + lane] = xr; F.a->out[O_S5IM_P + (size_t)(b * 32 + g) * 64 + lane] = xi; }
    __syncthreads();
}

constexpr size_t WS_RQ = WS_GATES, WS_BON = WS_END;
static_assert(WS_RQ + 64 * MiB <= WS_GATES + (size_t)MP * 2048 * 2 && WS_BON + 2048 * 64 * 4 <= 256 * MiB, "rwkv intermediates");
constexpr int A_PERS = 13 * RSLOT;
constexpr int A_XOFF = A_PERS + 2 * 64 * RL * 2 + 64 * 136 * 2;
static_assert(A_XOFF + 3 * 1024 <= MISC_OFF, "rwkv phase A LDS");
enum { A_AT = 0, A_BB = 1, A_KB = 2, A_ND = 3, A_N = 4, A_MAK = 5, A_RT = 6, A_ATT = 7, A_VT = 8, A_MRB = 9, A_MRK = 10, A_RHS = 11, A_TR = 12,
       A_BHT = 0, A_KHT = 1, A_WT = 2, A_ULT = 6 };
__device__ __forceinline__ float fsig(float x) { return __builtin_amdgcn_rcpf(1.0f + __expf(-x)); }
__device__ __forceinline__ float ftanh(float x) { return 1.0f - 2.0f * __builtin_amdgcn_rcpf(__expf(2.0f * x) + 1.0f); }
__device__ __forceinline__ void st_pq_h(LAS bf16* O, const f32x4 (&v)[2], int p0, int q0, int lane) {
#pragma unroll
    for (int tl = 0; tl < 2; ++tl) *(LAS v2u*)(O + (p0 + (lane & 15)) * RL + q0 + 16 * tl + 4 * (lane >> 4)) = (v2u){cvtpk(v[tl][0], v[tl][1]), cvtpk(v[tl][2], v[tl][3])};
}
__device__ __forceinline__ void st_qp_h(LAS bf16* O, const f32x4 (&v)[2], int p0, int q0, int lane) {
#pragma unroll
    for (int tl = 0; tl < 2; ++tl) { const unsigned a = cvtpk(v[tl][0], v[tl][1]), b = cvtpk(v[tl][2], v[tl][3]);
        LAS bf16* o = O + (q0 + 16 * tl + 4 * (lane >> 4)) * RL + p0 + (lane & 15);
        o[0] = (bf16)(a & 0xffffu); o[RL] = (bf16)(a >> 16); o[2 * RL] = (bf16)(b & 0xffffu); o[3 * RL] = (bf16)(b >> 16); }
}
__device__ __forceinline__ int swz_off(int r, int c) { return r * 64 + ((((c >> 3) ^ (r & 7))) << 3) + (c & 7); }
__device__ __forceinline__ void st_glob(bf16* G, const f32x4 (&v)[2], int p0, int q0, int lane) {
#pragma unroll
    for (int tl = 0; tl < 2; ++tl) *(GAS v2u*)(G + swz_off(p0 + (lane & 15), q0 + 16 * tl + 4 * (lane >> 4))) = (v2u){cvtpk(v[tl][0], v[tl][1]), cvtpk(v[tl][2], v[tl][3])};
}
#define ASL(s) ((LAS bf16*)(F.lds + (s) * RSLOT))
#define ZERO2 {{0.f, 0.f, 0.f, 0.f}, {0.f, 0.f, 0.f, 0.f}}

constexpr int DL = 24;
__device__ __forceinline__ bf16x8 ld16(const LAS bf16* Mx, int lane) {
    const v4u z = {0u, 0u, 0u, 0u}; const v4u v = *(const LAS v4u*)(Mx + (lane & 15) * DL + 8 * ((lane >> 4) & 1));
    return __builtin_bit_cast(bf16x8, (lane >> 4) < 2 ? v : z);
}
__device__ __forceinline__ void st16_pq(LAS bf16* O, const f32x4& v, int lane) { *(LAS v2u*)(O + (lane & 15) * DL + 4 * (lane >> 4)) = (v2u){cvtpk(v[0], v[1]), cvtpk(v[2], v[3])}; }
__device__ __forceinline__ void st16_qp(LAS bf16* O, const f32x4& v, int lane) { const unsigned a = cvtpk(v[0], v[1]), b = cvtpk(v[2], v[3]);
    LAS bf16* o = O + (4 * (lane >> 4)) * DL + (lane & 15); o[0] = (bf16)(a & 0xffffu); o[DL] = (bf16)(a >> 16); o[2 * DL] = (bf16)(b & 0xffffu); o[3 * DL] = (bf16)(b >> 16); }
struct APre { v2u c[2][3], p[2][3]; };
__device__ __forceinline__ void rwkvA_loadrkv(APre& P, const bf16* cur, const float* mu, size_t row, bool hasprev, int h, int q0, int lq) {
#pragma unroll
    for (int tl = 0; tl < 2; ++tl)
#pragma unroll
        for (int s = 0; s < 3; ++s) { const int col = 512 * s + 64 * h + q0 + 16 * tl + 4 * lq;
            P.c[tl][s] = *(const GAS v2u*)(cur + row * NSHIFT + col);
            const v2u pv = *(const GAS v2u*)(cur + (row - 1) * NSHIFT + col);
            P.p[tl][s] = hasprev ? pv : (v2u){0u, 0u}; }
}
__device__ __forceinline__ float rows_sum(float x) {
    float a = x, b = x;
    asm volatile("s_nop 1\n\tv_permlane16_swap_b32 %0, %1\n\ts_nop 1" : "+v"(a), "+v"(b));
    a += b; b = a;
    asm volatile("s_nop 1\n\tv_permlane32_swap_b32 %0, %1\n\ts_nop 1" : "+v"(a), "+v"(b));
    return a + b;
}
struct HC { f32x4 mu[2][3], w0[2], a0[2], ckk[2], cka[2], crk[2]; bf16x8 qw[2][2], qa[2][2], qg[4][2]; };
template <int PART>
__device__ __forceinline__ void rwkvA_loadhc(HC& C, Frame& F, const float* mu, const bf16* W2T, const bf16* A2T, const bf16* G2T, int h, int q0, int lane) {
    const int li = lane & 15, lq = lane >> 4;
#pragma unroll
    for (int tl = 0; tl < 2; ++tl) {
        const int jc = 64 * h + q0 + 16 * tl + 4 * lq;
        if (PART & 1) {
#pragma unroll
            for (int s = 0; s < 3; ++s) C.mu[tl][s] = *(const GAS f32x4*)(mu + 512 * s + jc);
            C.w0[tl] = *(const GAS f32x4*)(F.a->in[I_W0] + jc); C.a0[tl] = *(const GAS f32x4*)(F.a->in[I_A0] + jc);
            C.ckk[tl] = *(const GAS f32x4*)(F.a->in[I_KK] + jc); C.cka[tl] = *(const GAS f32x4*)(F.a->in[I_KA] + jc); C.crk[tl] = *(const GAS f32x4*)(F.a->in[I_RK] + jc);
        }
        if (PART & 2) {
            const size_t wrow = (size_t)(64 * h + q0 + 16 * tl + li);
#pragma unroll
            for (int ks = 0; ks < 2; ++ks) { C.qw[ks][tl] = *(const GAS bf16x8*)(W2T + wrow * 64 + 32 * ks + 8 * lq); C.qa[ks][tl] = *(const GAS bf16x8*)(A2T + wrow * 64 + 32 * ks + 8 * lq); }
#pragma unroll
            for (int ks = 0; ks < 4; ++ks) C.qg[ks][tl] = *(const GAS bf16x8*)(G2T + wrow * 128 + 32 * ks + 8 * lq);
        }
    }
}
__device__ __forceinline__ void rwkvA_unit(Frame& F, int b, int ch) {
    const int w = F.wave, lane0 = F.lane, tid0 = F.tid;
    const int p0 = 16 * (w >> 1), q0 = 32 * (w & 1);
    const bf16* cur = (const bf16*)(F.a->ws + WS_CUR); bf16* O = (bf16*)(F.a->ws + WS_O);
    const bf16* W2T = (const bf16*)(F.a->ws + WS_LORA); const bf16* A2T = W2T + 512 * 64; const bf16* G2T = A2T + 512 * 64;
    bf16* RQ = (bf16*)(F.a->ws + WS_RQ); float* BONB = (float*)(F.a->ws + WS_BON);
    const float* mu = F.a->in[I_MU];
    LAS bf16* WD = (LAS bf16*)(F.lds + A_PERS); LAS bf16* AD = WD + 64 * RL; LAS bf16* GD = AD + 64 * RL;
    LAS float* XCH = (LAS float*)(F.lds + A_XOFF); LAS float* LT = XCH + 256;
    const size_t row0 = (size_t)b * SEQ + ch * 64;
#pragma unroll
    for (int it = 0; it < 4; ++it) {
        const int item = it * 512 + tid0, t = item >> 5, vi = item & 31, col = 1536 + 8 * vi;
        const size_t row = row0 + t;
        const v4u c = *(const GAS v4u*)(cur + row * NSHIFT + col);
        v4u p = *(const GAS v4u*)(cur + (row - 1) * NSHIFT + col);
        if (!(ch + t > 0)) p = (v4u){0u, 0u, 0u, 0u};
        const f32x4 m0 = *(const GAS f32x4*)(mu + col), m1 = *(const GAS f32x4*)(mu + col + 4);
        float x[8];
        { const float c0 = bflo(c.x), c1 = bfhi(c.x), c2 = bflo(c.y), c3 = bfhi(c.y), c4 = bflo(c.z), c5 = bfhi(c.z), c6 = bflo(c.w), c7 = bfhi(c.w);
          x[0] = c0 + m0.x * (bflo(p.x) - c0); x[1] = c1 + m0.y * (bfhi(p.x) - c1); x[2] = c2 + m0.z * (bflo(p.y) - c2); x[3] = c3 + m0.w * (bfhi(p.y) - c3);
          x[4] = c4 + m1.x * (bflo(p.z) - c4); x[5] = c5 + m1.y * (bfhi(p.z) - c5); x[6] = c6 + m1.z * (bflo(p.w) - c6); x[7] = c7 + m1.w * (bfhi(p.w) - c7); }
        if (vi < 8) {
#pragma unroll
            for (int i = 0; i < 8; ++i) x[i] = ftanh(x[i]);
            *(LAS v4u*)(WD + t * RL + 8 * vi) = (v4u){cvtpk(x[0], x[1]), cvtpk(x[2], x[3]), cvtpk(x[4], x[5]), cvtpk(x[6], x[7])};
        } else if (vi < 16) {
            *(LAS v4u*)(AD + t * RL + 8 * (vi - 8)) = (v4u){cvtpk(x[0], x[1]), cvtpk(x[2], x[3]), cvtpk(x[4], x[5]), cvtpk(x[6], x[7])};
        } else {
#pragma unroll
            for (int i = 0; i < 8; ++i) x[i] = fsig(x[i]);
            *(LAS v4u*)(GD + t * 136 + 8 * (vi - 16)) = (v4u){cvtpk(x[0], x[1]), cvtpk(x[2], x[3]), cvtpk(x[4], x[5]), cvtpk(x[6], x[7])};
        }
    }
    RW_BAR();
    APre PN;
    rwkvA_loadrkv(PN, cur, mu, row0 + p0 + (lane0 & 15), (ch + p0 + (lane0 & 15)) > 0, 0, q0, lane0 >> 4);
    HC CN; { int l_ = lane0; asm volatile("" : "+v"(l_)); rwkvA_loadhc<3>(CN, F, mu, W2T, A2T, G2T, 0, q0, l_); }
#pragma unroll 1
    for (int h = 0; h < 8; ++h) {
        int lane = lane0; asm volatile("" : "+v"(lane));
        const int li = lane & 15, lq = lane >> 4;
        const size_t uidx = (size_t)((b * 8 + h) * 32 + ch);
        const HC C = CN;
        f32x4 vr[2], ag[2], gC[2], rtv[2], bhv[2], khv[2];
        {
        f32x4 rr[2], kr[2];
        {
            const APre PC = PN;
            rwkvA_loadrkv(PN, cur, mu, row0 + p0 + li, (ch + p0 + li) > 0, h < 7 ? h + 1 : 7, q0, lq);
#pragma unroll
            for (int tl = 0; tl < 2; ++tl)
#pragma unroll
                for (int s = 0; s < 3; ++s) {
                    const v2u c = PC.c[tl][s], p = PC.p[tl][s]; const f32x4 m = C.mu[tl][s];
                    const float c0 = bflo(c.x), c1 = bfhi(c.x), c2 = bflo(c.y), c3 = bfhi(c.y);
                    const f32x4 x = (f32x4){c0 + m.x * (bflo(p.x) - c0), c1 + m.y * (bfhi(p.x) - c1), c2 + m.z * (bflo(p.y) - c2), c3 + m.w * (bfhi(p.y) - c3)};
                    if (s == 0) rr[tl] = x; else if (s == 1) kr[tl] = x; else vr[tl] = x;
                }
        }
        f32x4 aw[2] = {C.w0[0], C.w0[1]}, aa[2] = {C.a0[0], C.a0[1]};
        ag[0] = (f32x4){0.f, 0.f, 0.f, 0.f}; ag[1] = ag[0]; asm volatile("" : "+v"(ag[0]), "+v"(ag[1]));
#pragma unroll
        for (int ks = 0; ks < 2; ++ks) {
            const bf16x8 pw = ldfrag(WD, p0, 32 * ks, lane), pa = ldfrag(AD, p0, 32 * ks, lane);
#pragma unroll
            for (int tl = 0; tl < 2; ++tl) { aw[tl] = mfma_safe(C.qw[ks][tl], pw, aw[tl], 0, 0, 0); aa[tl] = mfma_safe(C.qa[ks][tl], pa, aa[tl], 0, 0, 0); }
        }
#pragma unroll
        for (int ks = 0; ks < 4; ++ks) {
            const bf16x8 pg = *(const LAS bf16x8*)(GD + (p0 + li) * 136 + 32 * ks + 8 * lq);
#pragma unroll
            for (int tl = 0; tl < 2; ++tl) ag[tl] = mfma_safe(C.qg[ks][tl], pg, ag[tl], 0, 0, 0);
        }
#pragma unroll
        for (int tl = 0; tl < 2; ++tl) *(GAS v2u*)(O + (row0 + p0 + li) * OZP + 64 * h + q0 + 16 * tl + 4 * lq) = (v2u){cvtpk(ag[tl][0], ag[tl][1]), cvtpk(ag[tl][2], ag[tl][3])};
        f32x4 ldv[2], alv[2], kkv[2], kpv[2], Lc[2];
        float ss = 0.f, bon = 0.f;
#pragma unroll
        for (int tl = 0; tl < 2; ++tl) {
            const int jc = 64 * h + q0 + 16 * tl + 4 * lq;
            const f32x4 c_kk = C.ckk[tl], c_ka = C.cka[tl], c_rk = C.crk[tl];
#pragma unroll
            for (int r = 0; r < 4; ++r) {
                ldv[tl][r] = -0.6065306597126334f * fsig(aw[tl][r]);
                alv[tl][r] = fsig(aa[tl][r]);
                kkv[tl][r] = kr[tl][r] * c_kk[r]; ss += kkv[tl][r] * kkv[tl][r];
                kpv[tl][r] = kr[tl][r] * (1.0f + (alv[tl][r] - 1.0f) * c_ka[r]);
                bon += rr[tl][r] * kpv[tl][r] * c_rk[r];
                float x = ldv[tl][r];
                x += __builtin_bit_cast(float, __builtin_amdgcn_update_dpp(0, __builtin_bit_cast(int, x), 0x111, 0xf, 0xf, true));
                x += __builtin_bit_cast(float, __builtin_amdgcn_update_dpp(0, __builtin_bit_cast(int, x), 0x112, 0xf, 0xf, true));
                x += __builtin_bit_cast(float, __builtin_amdgcn_update_dpp(0, __builtin_bit_cast(int, x), 0x114, 0xf, 0xf, true));
                x += __builtin_bit_cast(float, __builtin_amdgcn_update_dpp(0, __builtin_bit_cast(int, x), 0x118, 0xf, 0xf, true));
                Lc[tl][r] = x;
            }
        }
        ss = rows_sum(ss); bon = rows_sum(bon);
        if (lane < 16) { XCH[(w * 16 + li) * 2] = ss; XCH[(w * 16 + li) * 2 + 1] = bon; }
        if (li == 15) {
#pragma unroll
            for (int tl = 0; tl < 2; ++tl) *(LAS f32x4*)(LT + (w >> 1) * 64 + q0 + 16 * tl + 4 * lq) = Lc[tl];
        }
        RW_BAR();
        { const int wp = w ^ 1; ss += XCH[(wp * 16 + li) * 2]; bon += XCH[(wp * 16 + li) * 2 + 1]; }
        if ((w & 1) == 0 && lane < 16) BONB[uidx * 64 + p0 + li] = bon;
        const float inv = __builtin_amdgcn_rcpf(fmaxf(sqrtf(ss), 1e-12f));
#pragma unroll
        for (int tl = 0; tl < 2; ++tl) {
            const int jq = q0 + 16 * tl + 4 * lq;
            f32x4 off = {0.f, 0.f, 0.f, 0.f}, tot = {0.f, 0.f, 0.f, 0.f};
#pragma unroll
            for (int pb = 0; pb < 4; ++pb) { const f32x4 x = *(const LAS f32x4*)(LT + pb * 64 + jq); tot += x; if (pb < (w >> 1)) off += x; }
            f32x4 at, bb, kb;
#pragma unroll
            for (int r = 0; r < 4; ++r) {
                const float Lt = Lc[tl][r] + off[r], gt = __expf(Lt), gp = __expf(Lt - ldv[tl][r]), gi = __expf(-Lt), gh = __expf(tot[r] - Lt);
                gC[tl][r] = __expf(tot[r]);
                const float kn = kkv[tl][r] * inv, bv = kn * alv[tl][r];
                at[r] = -kn * gp; rtv[tl][r] = rr[tl][r] * gt; bb[r] = bv * gi; kb[r] = kpv[tl][r] * gi; bhv[tl][r] = bv * gh; khv[tl][r] = kpv[tl][r] * gh;
            }
            const int ro = (p0 + li) * RL + jq;
            *(LAS v2u*)(ASL(A_AT) + ro) = (v2u){cvtpk(at[0], at[1]), cvtpk(at[2], at[3])};
            *(LAS v2u*)(ASL(A_RT) + ro) = (v2u){cvtpk(rtv[tl][0], rtv[tl][1]), cvtpk(rtv[tl][2], rtv[tl][3])};
            *(LAS v2u*)(ASL(A_BB) + ro) = (v2u){cvtpk(bb[0], bb[1]), cvtpk(bb[2], bb[3])};
            *(LAS v2u*)(ASL(A_KB) + ro) = (v2u){cvtpk(kb[0], kb[1]), cvtpk(kb[2], kb[3])};
            { const unsigned a0 = cvtpk(at[0], at[1]), a1 = cvtpk(at[2], at[3]), v0 = cvtpk(vr[tl][0], vr[tl][1]), v1 = cvtpk(vr[tl][2], vr[tl][3]);
              const int co = jq * RL + p0 + li;
              LAS bf16* pa = ASL(A_ATT) + co; LAS bf16* pv = ASL(A_VT) + co;
              pa[0] = (bf16)(a0 & 0xffffu); pa[RL] = (bf16)(a0 >> 16); pa[2 * RL] = (bf16)(a1 & 0xffffu); pa[3 * RL] = (bf16)(a1 >> 16);
              pv[0] = (bf16)(v0 & 0xffffu); pv[RL] = (bf16)(v0 >> 16); pv[2 * RL] = (bf16)(v1 & 0xffffu); pv[3 * RL] = (bf16)(v1 >> 16); }
        }
        RW_BAR();
        }
        f32x4 ndiag = {0.f, 0.f, 0.f, 0.f};
        {
            f32x4 n_[2] = ZERO2, mak[2] = ZERO2, mrb[2] = ZERO2, mrk[2] = ZERO2; asm volatile("" : "+v"(n_[0]), "+v"(n_[1]), "+v"(mak[0]), "+v"(mak[1]), "+v"(mrb[0]), "+v"(mrb[1]), "+v"(mrk[0]), "+v"(mrk[1]));
            mm2<2>(n_, ASL(A_AT), ASL(A_BB), p0, q0, lane); mm2<2>(mak, ASL(A_AT), ASL(A_KB), p0, q0, lane);
            mm2<2>(mrb, ASL(A_RT), ASL(A_BB), p0, q0, lane); mm2<2>(mrk, ASL(A_RT), ASL(A_KB), p0, q0, lane);
#pragma unroll
            for (int tl = 0; tl < 2; ++tl) {
#pragma unroll
                for (int r = 0; r < 4; ++r) { const int t = p0 + li, s_ = q0 + 16 * tl + 4 * lq + r;
                    if (!(t > s_)) { n_[tl][r] = 0.f; mak[tl][r] = 0.f; } if (!(t >= s_)) { mrb[tl][r] = 0.f; mrk[tl][r] = 0.f; } }
                if (q0 + 16 * tl == p0) ndiag = n_[tl];
            }
            st_pq_h(ASL(A_N), n_, p0, q0, lane); st_pq_h(ASL(A_MAK), mak, p0, q0, lane); st_pq_h(ASL(A_MRB), mrb, p0, q0, lane); st_pq_h(ASL(A_MRK), mrk, p0, q0, lane);
        }
        RW_BAR();
        rwkvA_loadhc<2>(CN, F, mu, W2T, A2T, G2T, h < 7 ? h + 1 : 7, q0, lane);
        {
            f32x4 rh[2] = ZERO2; asm volatile("" : "+v"(rh[0]), "+v"(rh[1]));
            mm2<2>(rh, ASL(A_VT), ASL(A_MAK), p0, q0, lane);
            st_pq_h(ASL(A_RHS), rh, p0, q0, lane);
            st_qp_h(ASL(A_BHT), bhv, p0, q0, lane); st_qp_h(ASL(A_KHT), khv, p0, q0, lane);
            if (q0 == (p0 & 32)) {
                LAS bf16* SP = ASL(A_ND) + (p0 >> 4) * (3 * 16 * DL); LAS bf16* SPT = SP + 16 * DL; LAS bf16* ST = SPT + 16 * DL;
                f32x4 Tb = ndiag, Pb = ndiag;
#pragma unroll
                for (int r = 0; r < 4; ++r) if (li == 4 * lq + r) Tb[r] += 1.0f;
#pragma unroll
                for (int lev = 0; lev < 4; ++lev) {
                    st16_pq(SP, Pb, lane); st16_qp(SPT, Pb, lane); st16_pq(ST, Tb, lane);
                    LDS_WAIT();
                    const bf16x8 fp = ld16(SP, lane), fpt = ld16(SPT, lane), ft = ld16(ST, lane);
                    if (lev > 0) Tb = mfma_safe(fpt, ft, Tb, 0, 0, 0);
                    if (lev < 3) { f32x4 z = {0.f, 0.f, 0.f, 0.f}; asm volatile("" : "+v"(z)); Pb = mfma_safe(fpt, fp, z, 0, 0, 0); }
                    LDS_WAIT();
                }
                st16_pq(ASL(A_TR) + (p0 >> 4) * (16 * DL), Tb, lane);
            }
        }
        RW_BAR();
        rwkvA_loadhc<1>(CN, F, mu, W2T, A2T, G2T, h < 7 ? h + 1 : 7, q0, lane);
        {
            const int ct = w & 3;
            const LAS bf16* src = (w < 4 ? ASL(A_ATT) : ASL(A_RHS)) + (16 * ct + li) * RL + 4 * lq;
            LAS bf16* XT = (w < 4 ? ASL(A_WT) : ASL(A_ULT)) + (16 * ct + li) * RL + 4 * lq;
            const LAS bf16* Nr = ASL(A_N) + li * RL + 4 * lq;
            const LAS bf16* Dr = ASL(A_TR) + li * DL + 4 * lq;
            v2u rh_[4], d_[4];
#pragma unroll
            for (int bb = 0; bb < 4; ++bb) { rh_[bb] = *(const LAS v2u*)(src + 16 * bb); d_[bb] = *(const LAS v2u*)(Dr + bb * (16 * DL)); }
            const v2u n10 = *(const LAS v2u*)(Nr + 16 * RL), n20 = *(const LAS v2u*)(Nr + 32 * RL), n21 = *(const LAS v2u*)(Nr + 32 * RL + 16);
            const v2u n30 = *(const LAS v2u*)(Nr + 48 * RL), n31 = *(const LAS v2u*)(Nr + 48 * RL + 16), n32 = *(const LAS v2u*)(Nr + 48 * RL + 32);
            LDS_WAIT();
#define SUB_FR(lo, hi) __builtin_bit_cast(bf16x8, ((v4u){(lo).x, (lo).y, (hi).x, (hi).y}))
#define SUB_PK(a)      ((v2u){cvtpk((a)[0], (a)[1]), cvtpk((a)[2], (a)[3])})
#define SUB_UNP(u)     ((f32x4){bflo((u).x), bfhi((u).x), bflo((u).y), bfhi((u).y)})
            const v2u z2 = {0u, 0u};
            f32x4 x[4];
#pragma unroll
            for (int bb = 0; bb < 4; ++bb) {
                f32x4 y = SUB_UNP(rh_[bb]);
                if (bb == 1) y = mfma_safe(SUB_FR(n10, z2), SUB_FR(SUB_PK(x[0]), z2), y, 0, 0, 0);
                if (bb == 2) y = mfma_safe(SUB_FR(n20, n21), SUB_FR(SUB_PK(x[0]), SUB_PK(x[1])), y, 0, 0, 0);
                if (bb == 3) { y = mfma_safe(SUB_FR(n30, n31), SUB_FR(SUB_PK(x[0]), SUB_PK(x[1])), y, 0, 0, 0); y = mfma_safe(SUB_FR(n32, z2), SUB_FR(SUB_PK(x[2]), z2), y, 0, 0, 0); }
                f32x4 z = {0.f, 0.f, 0.f, 0.f}; asm volatile("" : "+v"(z));
                x[bb] = mfma_safe(SUB_FR(d_[bb], z2), SUB_FR(SUB_PK(y), z2), z, 0, 0, 0);
                *(LAS v2u*)(XT + 16 * bb) = SUB_PK(x[bb]);
            }
#undef SUB_FR
#undef SUB_PK
#undef SUB_UNP
        }
        RW_BAR();
        {
            bf16* base = RQ + uidx * 16384;
            f32x4 qv[2] = {rtv[0], rtv[1]}, yl[2] = ZERO2, gt[2] = ZERO2, hv[2] = ZERO2; asm volatile("" : "+v"(yl[0]), "+v"(yl[1]), "+v"(gt[0]), "+v"(gt[1]), "+v"(hv[0]), "+v"(hv[1]));
            mm2<2>(qv, ASL(A_MRB), ASL(A_WT), p0, q0, lane);
            mm2<2>(yl, ASL(A_MRB), ASL(A_ULT), p0, q0, lane); mm2<2>(yl, ASL(A_MRK), ASL(A_VT), p0, q0, lane);
            mm2<2>(gt, ASL(A_BHT), ASL(A_WT), p0, q0, lane);
            mm2<2>(hv, ASL(A_ULT), ASL(A_BHT), p0, q0, lane); mm2<2>(hv, ASL(A_VT), ASL(A_KHT), p0, q0, lane);
#pragma unroll
            for (int tl = 0; tl < 2; ++tl)
#pragma unroll
                for (int r = 0; r < 4; ++r) if (p0 + li == q0 + 16 * tl + 4 * lq + r) gt[tl][r] += gC[tl][r];
            st_glob(base, qv, p0, q0, lane); st_glob(base + 4096, yl, p0, q0, lane); st_glob(base + 8192, gt, p0, q0, lane); st_glob(base + 12288, hv, p0, q0, lane);
        }
        RW_BAR();
    }
}

constexpr int B_BUF = 2 * RSLOT, B_XOFF = B_BUF + 2 * 32768;
struct BPre { v4u raw[4]; v2u g2[2], cc[2], cp[2]; float bon; };
template <int PART>
__device__ __forceinline__ void rwkvB_load(BPre& P, const bf16* RQ, const float* BONB, const bf16* cur, const bf16* O, int b, int h, int ch, int p0, int q0, int lane, int w) {
    const int li = lane & 15, lq = lane >> 4;
    const size_t uidx = (size_t)((b * 8 + h) * 32 + ch), row = (size_t)b * SEQ + ch * 64 + p0 + li;
    if (PART & 1) {
        const unsigned char* blk = (const unsigned char*)(RQ + uidx * 16384) + w * 4096 + lane * 16;
#pragma unroll
        for (int i = 0; i < 4; ++i) P.raw[i] = *(const GAS v4u*)(blk + i * 1024);
    }
    if (PART & 2) {
        const bool hasprev = (ch + p0 + li) > 0;
#pragma unroll
        for (int tl = 0; tl < 2; ++tl) {
            const int col = 1024 + 64 * h + q0 + 16 * tl + 4 * lq;
            P.g2[tl] = *(const GAS v2u*)(O + row * OZP + 64 * h + q0 + 16 * tl + 4 * lq);
            P.cc[tl] = *(const GAS v2u*)(cur + row * NSHIFT + col);
            { const v2u pv = *(const GAS v2u*)(cur + (row - 1) * NSHIFT + col);
              P.cp[tl] = hasprev ? pv : (v2u){0u, 0u}; }
        }
        P.bon = BONB[uidx * 64 + p0 + li];
    }
}
__device__ __forceinline__ bf16x8 ldfrag_sw(const LAS bf16* Mx, int row0, int k0, int lane) { const int r = row0 + (lane & 15), c = (k0 >> 3) + (lane >> 4); return *(const LAS bf16x8*)(Mx + r * 64 + ((c ^ (r & 7)) << 3)); }
__device__ __forceinline__ void rwkvB_step(Frame& F, const BPre& Pn, const BPre& Pc, f32x4 (&Sreg)[2], const f32x4 (&mu4)[2], const f32x4 (&lnw)[2], const f32x4 (&lnb)[2], bf16* O, size_t rowmask, int b, int h, int ch, int p0, int q0, int lane, int w) {
    const int li = lane & 15, lq = lane >> 4, pp = ch & 1;
    LAS float* XCH2 = (LAS float*)(F.lds + B_XOFF);
    const LAS bf16* Sb = ASL(pp); LAS bf16* Sn = ASL(pp ^ 1);
    const LAS bf16* Bc = (const LAS bf16*)(F.lds + B_BUF + pp * 32768);
    {   LAS unsigned char* Bn = F.lds + B_BUF + (pp ^ 1) * 32768 + w * 4096 + lane * 16;
#pragma unroll
        for (int i = 0; i < 4; ++i) *(LAS v4u*)(Bn + i * 1024) = Pn.raw[i]; }
    f32x4 Yreg[2], Sacc[2];
#pragma unroll
    for (int tl = 0; tl < 2; ++tl) { const int o = swz_off(p0 + li, q0 + 16 * tl + 4 * lq);
        const v2u yl = *(const LAS v2u*)(Bc + 4096 + o), hh = *(const LAS v2u*)(Bc + 12288 + o);
        Yreg[tl] = (f32x4){bflo(yl.x), bfhi(yl.x), bflo(yl.y), bfhi(yl.y)}; Sacc[tl] = (f32x4){bflo(hh.x), bfhi(hh.x), bflo(hh.y), bfhi(hh.y)}; }
#pragma unroll
    for (int ks = 0; ks < 2; ++ks) {
        const bf16x8 sp = ldfrag(Sb, p0, 32 * ks, lane);
        const bf16x8 qf = ldfrag_sw(Bc, p0, 32 * ks, lane);
#pragma unroll
        for (int tl = 0; tl < 2; ++tl) {
            const bf16x8 sq = ldfrag(Sb, q0 + 16 * tl, 32 * ks, lane);
            const bf16x8 gq = ldfrag_sw(Bc + 8192, q0 + 16 * tl, 32 * ks, lane);
            Yreg[tl] = mfma_safe(sq, qf, Yreg[tl], 0, 0, 0);
            Sacc[tl] = mfma_safe(gq, sp, Sacc[tl], 0, 0, 0);
        }
    }
    st_pq_h(Sn, Sacc, p0, q0, lane);
    Sreg[0] = Sacc[0]; Sreg[1] = Sacc[1];
    float s = 0.f;
#pragma unroll
    for (int tl = 0; tl < 2; ++tl) s += (Yreg[tl][0] + Yreg[tl][1]) + (Yreg[tl][2] + Yreg[tl][3]);
    s = rows_sum(s);
    const float mw = s * (1.0f / 32.0f); float q = 0.f;
#pragma unroll
    for (int tl = 0; tl < 2; ++tl)
#pragma unroll
        for (int r = 0; r < 4; ++r) { const float d = Yreg[tl][r] - mw; q += d * d; }
    q = rows_sum(q);
    LAS float* X2 = XCH2 + pp * 256;
    if (lane < 16) { X2[(w * 16 + li) * 2] = mw; X2[(w * 16 + li) * 2 + 1] = q; }
    RW_BAR();
    const float mo = X2[((w ^ 1) * 16 + li) * 2], qo = X2[((w ^ 1) * 16 + li) * 2 + 1];
    const float mean = 0.5f * (mw + mo), dm = mw - mo, m2 = q + qo + 16.0f * dm * dm;
    const float rstd = __builtin_amdgcn_rsqf(m2 * (1.0f / 64.0f) + GN_EPS);
    const size_t row = (size_t)b * SEQ + ch * 64 + p0 + li;
#pragma unroll
    for (int tl = 0; tl < 2; ++tl) {
        const float c0 = bflo(Pc.cc[tl].x), c1 = bfhi(Pc.cc[tl].x), c2 = bflo(Pc.cc[tl].y), c3 = bfhi(Pc.cc[tl].y);
        const f32x4 vr = (f32x4){c0 + mu4[tl].x * (bflo(Pc.cp[tl].x) - c0), c1 + mu4[tl].y * (bfhi(Pc.cp[tl].x) - c1), c2 + mu4[tl].z * (bflo(Pc.cp[tl].y) - c2), c3 + mu4[tl].w * (bfhi(Pc.cp[tl].y) - c3)};
        const f32x4 gg = (f32x4){bflo(Pc.g2[tl].x), bfhi(Pc.g2[tl].x), bflo(Pc.g2[tl].y), bfhi(Pc.g2[tl].y)};
        float o[4];
#pragma unroll
        for (int r = 0; r < 4; ++r) o[r] = ((Yreg[tl][r] - mean) * rstd * lnw[tl][r] + lnb[tl][r] + Pc.bon * vr[r]) * gg[r];
        *(GAS v2u*)(O + (row & rowmask) * OZP + 64 * h + q0 + 16 * tl + 4 * lq) = (v2u){cvtpk(o[0], o[1]), cvtpk(o[2], o[3])};
    }
}
__device__ __forceinline__ void rwkvB_unit(Frame& F, int b, int h, bf16* Oout, size_t rowmask) {
    const int w = F.wave, lane0 = F.lane;
    const int p0 = 16 * (w >> 1), q0 = 32 * (w & 1);
    const bf16* cur = (const bf16*)(F.a->ws + WS_CUR); const bf16* O = (const bf16*)(F.a->ws + WS_O);
    const bf16* RQ = (const bf16*)(F.a->ws + WS_RQ); const float* BONB = (const float*)(F.a->ws + WS_BON);
    f32x4 Sreg[2] = ZERO2;
    st_pq_h(ASL(0), Sreg, p0, q0, lane0);
    f32x4 mu4[2], lnw[2], lnb[2];
#pragma unroll
    for (int tl = 0; tl < 2; ++tl) { const int jc = 64 * h + q0 + 16 * tl + 4 * (lane0 >> 4);
        mu4[tl] = *(const GAS f32x4*)(F.a->in[I_MU] + 1024 + jc); lnw[tl] = *(const GAS f32x4*)(F.a->in[I_LNW] + jc); lnb[tl] = *(const GAS f32x4*)(F.a->in[I_LNB] + jc); }
    constexpr int NCH = SEQ / 64;
    static_assert(NCH % 4 == 0, "phase B loop shape");
#define BLOAD(PART_, P_, c_) rwkvB_load<PART_>(P_, RQ, BONB, cur, O, b, h, (c_) < NCH ? (c_) : NCH - 1, p0, q0, lane, w)
#define BSTEP(Pn_, Pc_, c_) rwkvB_step(F, Pn_, Pc_, Sreg, mu4, lnw, lnb, Oout, rowmask, b, h, (c_), p0, q0, lane, w)
    BPre P0, P1, P2, P3;
    {   int lane = lane0;
        BLOAD(3, P0, 0); BLOAD(3, P1, 1); BLOAD(3, P2, 2); BLOAD(1, P3, 3);
        LAS unsigned char* B0 = F.lds + B_BUF + w * 4096 + lane * 16;
#pragma unroll
        for (int i = 0; i < 4; ++i) *(LAS v4u*)(B0 + i * 1024) = P0.raw[i];
    }
    RW_BAR();
#pragma unroll 1
    for (int ch = 0; ch < NCH; ch += 4) {
        int lane = lane0; asm volatile("" : "+v"(lane));
        BLOAD(2, P3, ch + 3); BLOAD(1, P0, ch + 4); BSTEP(P1, P0, ch);
        BLOAD(2, P0, ch + 4); BLOAD(1, P1, ch + 5); BSTEP(P2, P1, ch + 1);
        BLOAD(2, P1, ch + 5); BLOAD(1, P2, ch + 6); BSTEP(P3, P2, ch + 2);
        BLOAD(2, P2, ch + 6); BLOAD(1, P3, ch + 7); BSTEP(P0, P3, ch + 3);
    }
#undef BLOAD
#undef BSTEP
    {
        const int li = lane0 & 15, lq = lane0 >> 4;
        float* so = F.a->out + O_WKV_P + ((size_t)(b * 8 + h) * 64 + p0 + li) * 64 + q0 + 4 * lq;
#pragma unroll
        for (int tl = 0; tl < 2; ++tl) *(GAS f32x4*)(so + 16 * tl) = Sreg[tl];
    }
}

__device__ __forceinline__ void sample_mix_unit(Frame& F, int unit) {
    const int lane = F.lane, w = F.wave, li = lane & 15, lq = lane >> 4;
    const int T = 2 * unit + (w >> 2), strip = T & 63, rb = T >> 6, kq = w & 3;
    const bf16* OZ = (const bf16*)(F.a->ws + WS_OZ); const bf16* GPT = (const bf16*)(F.a->ws + WS_GPT);
    const bf16* gates = (const bf16*)(F.a->ws + WS_GATES); bf16* MMp = (bf16*)(F.a->ws + WS_S5IN);
    const size_t arow = (size_t)(MP + 16 * rb + li) * OZP + 8 * lq + 128 * kq;
    const int c = 16 * strip + li;
    const size_t vrow = (size_t)(256 * (c >> 7) + (c & 127)) * 1024 + 8 * lq + 128 * kq, grow = vrow + 128 * 1024, prow = (size_t)c * 1024 + 512 + 8 * lq + 128 * kq;
    const size_t row = (size_t)MP + 16 * rb + li; const int col = 16 * strip + 4 * lq;
    bf16x8 az[4], ao[4], bv[4], bg[4], bp[4];
#pragma unroll
    for (int i = 0; i < 4; ++i) { az[i] = *(const GAS bf16x8*)(OZ + arow + 32 * i); ao[i] = *(const GAS bf16x8*)(OZ + arow + 512 + 32 * i);
        bv[i] = *(const GAS bf16x8*)(GPT + vrow + 32 * i); bg[i] = *(const GAS bf16x8*)(GPT + grow + 32 * i); bp[i] = *(const GAS bf16x8*)(GPT + prow + 32 * i); }
    const v2u g1 = *(const GAS v2u*)(gates + row * 2048 + col), g2 = *(const GAS v2u*)(gates + row * 2048 + 1024 + col);
    f32x4 av = {0.f, 0.f, 0.f, 0.f}, ag = av, ar = av; asm volatile("" : "+v"(av), "+v"(ag), "+v"(ar));
#pragma unroll
    for (int i = 0; i < 4; ++i) { av = mfma_safe(bv[i], az[i], av, 0, 0, 0); ag = mfma_safe(bg[i], az[i], ag, 0, 0, 0); ar = mfma_safe(bp[i], ao[i], ar, 0, 0, 0); }
    LAS f32x4* X = (LAS f32x4*)F.lds + (w * 3) * 64 + lane;
    if (kq) { X[0] = av; X[64] = ag; X[128] = ar; }
    RW_BAR();
    if (kq == 0) {
#pragma unroll
        for (int q = 1; q < 4; ++q) { av += X[(q * 3) * 64]; ag += X[(q * 3 + 1) * 64]; ar += X[(q * 3 + 2) * 64]; }
        const float m0 = bflo(g1.x) * (av[0] * fsig(ag[0])) + bflo(g2.x) * ar[0], m1 = bfhi(g1.x) * (av[1] * fsig(ag[1])) + bfhi(g2.x) * ar[1];
        const float m2 = bflo(g1.y) * (av[2] * fsig(ag[2])) + bflo(g2.y) * ar[2], m3 = bfhi(g1.y) * (av[3] * fsig(ag[3])) + bfhi(g2.y) * ar[3];
        *(GAS v2u*)(MMp + row * 1024 + col) = (v2u){cvtpk(m0, m1), cvtpk(m2, m3)};
    }
    RW_BAR();
}

struct S5Par { float lbr, lbi; float bbr[16], bbi[16]; };
__device__ __forceinline__ void s5_params(Frame& F, int g, int n, S5Par& P, double& lbr_d, double& lbi_d) {
    const double dt = exp((double)F.a->in[I_LOGDT][g]);
    const double lr = (double)F.a->in[I_LAMRE][g * 64 + n], li = (double)F.a->in[I_LAMIM][g * 64 + n];
    const double mag = exp(lr * dt), ang = li * dt;
    const double lbr = mag * cos(ang), lbi = mag * sin(ang);
    const double den = lr * lr + li * li, numr = lbr - 1.0;
    const double kr = (numr * lr + lbi * li) / den, ki = (lbi * lr - numr * li) / den;
    lbr_d = lbr; lbi_d = lbi; P.lbr = (float)lbr; P.lbi = (float)lbi;
    const float* bre = F.a->in[I_BRE] + (size_t)(g * 64 + n) * 16; const float* bim = F.a->in[I_BIM] + (size_t)(g * 64 + n) * 16;
    const float krf = (float)kr, kif = (float)ki;
#pragma unroll
    for (int c = 0; c < 16; ++c) { const float br = bre[c], bi = bim[c]; P.bbr[c] = krf * br - kif * bi; P.bbi[c] = krf * bi + kif * br; }
}
__device__ __forceinline__ void s5_prompt_unit(Frame& F, int b, int g) {
    LAS float* CRE = (LAS float*)F.lds;
    LAS float* CIM = CRE + 16 * 68;
    LAS float* ERE = CIM + 16 * 68;
    LAS float* EIM = ERE + 8 * 64;
    LAS float* WV = EIM + 8 * 64 + F.wave * (256 + 2 * 16 * 68);
    LAS float* UB = WV;
    LAS float* XRE = WV + 256;
    LAS float* XIM = XRE + 16 * 68;
    const int n = F.lane, w = F.wave;
    const bf16* s5in = (const bf16*)(F.a->ws + WS_S5IN); bf16* Z = (bf16*)(F.a->ws + WS_Z);
    S5Par P; double lbr_d, lbi_d; s5_params(F, g, n, P, lbr_d, lbi_d);
    for (int i = F.tid; i < 1024; i += 512) { const int c = i >> 6, nn = i & 63; CRE[c * 68 + nn] = F.a->in[I_CRE][g * 1024 + i]; CIM[c * 68 + nn] = F.a->in[I_CIM][g * 1024 + i]; }
    const int tok = F.lane >> 2, q = F.lane & 3;
    const size_t rowbase = (size_t)b * SEQ + 256 * w;
    float xr = 0.f, xi = 0.f;
#pragma unroll 1
    for (int blk = 0; blk < 16; ++blk) {
        const v2u raw = *(const GAS v2u*)(s5in + (rowbase + blk * 16 + tok) * 512 + 16 * g + 4 * q);
        *(LAS f32x4*)(UB + tok * 16 + 4 * q) = (f32x4){bflo(raw.x), bfhi(raw.x), bflo(raw.y), bfhi(raw.y)};
        LDS_WAIT();
#pragma unroll 2
        for (int i = 0; i < 16; ++i) {
            float u[16];
#pragma unroll
            for (int k = 0; k < 4; ++k) { const f32x4 t = *(const LAS f32x4*)(UB + i * 16 + 4 * k); u[4 * k] = t.x; u[4 * k + 1] = t.y; u[4 * k + 2] = t.z; u[4 * k + 3] = t.w; }
            float bur = 0.f, bui = 0.f;
#pragma unroll
            for (int c = 0; c < 16; ++c) { bur += P.bbr[c] * u[c]; bui += P.bbi[c] * u[c]; }
            const float nr = P.lbr * xr - P.lbi * xi + bur, ni = P.lbr * xi + P.lbi * xr + bui; xr = nr; xi = ni;
        }
        LDS_WAIT();
    }
    ERE[w * 64 + n] = xr; EIM[w * 64 + n] = xi;
    __syncthreads();
    {
        double pr = lbr_d, pi = lbi_d;
#pragma unroll
        for (int s = 0; s < 8; ++s) { const double t = pr * pr - pi * pi; pi = 2.0 * pr * pi; pr = t; }
        const float l256r = (float)pr, l256i = (float)pi;
        float cr = 0.f, ci = 0.f;
        for (int ww = 0; ww < w; ++ww) { const float er = ERE[ww * 64 + n], ei = EIM[ww * 64 + n]; const float t = l256r * cr - l256i * ci + er; ci = l256r * ci + l256i * cr + ei; cr = t; }
        xr = cr; xi = ci;
    }
    float dco[4];
#pragma unroll
    for (int k = 0; k < 4; ++k) dco[k] = F.a->in[I_S5D][16 * g + 4 * q + k];
#pragma unroll 1
    for (int blk = 0; blk < 16; ++blk) {
        const v2u raw = *(const GAS v2u*)(s5in + (rowbase + blk * 16 + tok) * 512 + 16 * g + 4 * q);
        *(LAS f32x4*)(UB + tok * 16 + 4 * q) = (f32x4){bflo(raw.x), bfhi(raw.x), bflo(raw.y), bfhi(raw.y)};
        LDS_WAIT();
#pragma unroll 2
        for (int i = 0; i < 16; ++i) {
            float u[16];
#pragma unroll
            for (int k = 0; k < 4; ++k) { const f32x4 t = *(const LAS f32x4*)(UB + i * 16 + 4 * k); u[4 * k] = t.x; u[4 * k + 1] = t.y; u[4 * k + 2] = t.z; u[4 * k + 3] = t.w; }
            float bur = 0.f, bui = 0.f;
#pragma unroll
            for (int c = 0; c < 16; ++c) { bur += P.bbr[c] * u[c]; bui += P.bbi[c] * u[c]; }
            const float nr = P.lbr * xr - P.lbi * xi + bur, ni = P.lbr * xi + P.lbi * xr + bui; xr = nr; xi = ni;
            XRE[i * 68 + n] = xr; XIM[i * 68 + n] = xi;
        }
        LDS_WAIT();
        float acc[4] = {0.f, 0.f, 0.f, 0.f};
#pragma unroll 2
        for (int n4 = 0; n4 < 16; ++n4) {
            const f32x4 a = *(const LAS f32x4*)(XRE + tok * 68 + 4 * n4), bb = *(const LAS f32x4*)(XIM + tok * 68 + 4 * n4);
#pragma unroll
            for (int k = 0; k < 4; ++k) { const f32x4 cr = *(const LAS f32x4*)(CRE + (4 * q + k) * 68 + 4 * n4), ci = *(const LAS f32x4*)(CIM + (4 * q + k) * 68 + 4 * n4);
                acc[k] += (cr.x * a.x + cr.y * a.y + cr.z * a.z + cr.w * a.w) - (ci.x * bb.x + ci.y * bb.y + ci.z * bb.z + ci.w * bb.w); }
        }
        const f32x4 uu = *(const LAS f32x4*)(UB + tok * 16 + 4 * q);
        const float z0 = gelu_tanh(acc[0] + dco[0] * uu.x), z1 = gelu_tanh(acc[1] + dco[1] * uu.y), z2 = gelu_tanh(acc[2] + dco[2] * uu.z), z3 = gelu_tanh(acc[3] + dco[3] * uu.w);
        *(GAS v2u*)(Z + (rowbase + blk * 16 + tok) * 512 + 16 * g + 4 * q) = (v2u){pk2(z0, z1), pk2(z2, z3)};
        LDS_WAIT();
    }
    if (w == 7) { F.a->out[O_S5RE_P + (size_t)(b * 32 + g) * 64 + n] = xr; F.a->out[O_S5IM_P + (size_t)(b * 32 + g) * 64 + n] = xi; }
    __syncthreads();
}
__device__ __forceinline__ void s5_sample_unit(Frame& F, int bs) {
    const int n = F.lane;
    const bf16* s5in = (const bf16*)(F.a->ws + WS_S5IN); bf16* Z = (bf16*)(F.a->ws + WS_Z);
    const size_t row = (size_t)MP + bs;
    for (int gi = 0; gi < 4; ++gi) {
        const int g = 4 * F.wave + gi;
        S5Par P;
        { const f32x4 pn = *(const GAS f32x4*)((const float*)(F.a->ws + WS_S5PAR) + (size_t)(g * 64 + n) * 8);
          P.lbr = pn.x; P.lbi = pn.y;
          const float* bre = F.a->in[I_BRE] + (size_t)(g * 64 + n) * 16; const float* bim = F.a->in[I_BIM] + (size_t)(g * 64 + n) * 16;
#pragma unroll
          for (int c = 0; c < 16; ++c) { const float br = bre[c], bi = bim[c]; P.bbr[c] = pn.z * br - pn.w * bi; P.bbi[c] = pn.z * bi + pn.w * br; } }
        float u[16];
#pragma unroll
        for (int c = 0; c < 16; ++c) u[c] = bf2f(s5in[row * 512 + 16 * g + c]);
        float bur = 0.f, bui = 0.f;
#pragma unroll
        for (int c = 0; c < 16; ++c) { bur += P.bbr[c] * u[c]; bui += P.bbi[c] * u[c]; }
        const float hr = F.a->in[I_S5RE][(size_t)(bs * 32 + g) * 64 + n], hi = F.a->in[I_S5IM][(size_t)(bs * 32 + g) * 64 + n];
        const float xr = P.lbr * hr - P.lbi * hi + bur, xi = P.lbr * hi + P.lbi * hr + bui;
        F.a->out[O_S5RE_S + (size_t)(bs * 32 + g) * 64 + n] = xr; F.a->out[O_S5IM_S + (size_t)(bs * 32 + g) * 64 + n] = xi;
        float myz = 0.f;
#pragma unroll
        for (int c = 0; c < 16; ++c) {
            const float y = wave_sum(F.a->in[I_CRE][(size_t)(g * 16 + c) * 64 + n] * xr - F.a->in[I_CIM][(size_t)(g * 16 + c) * 64 + n] * xi);
            const float z = gelu_tanh(y + F.a->in[I_S5D][16 * g + c] * u[c]);
            if (n == c) myz = z;
        }
        if (n < 16) Z[row * OZP + 16 * g + n] = (bf16)f2bf(myz);
    }
}

constexpr int RW_R = 0, RW_DEC = 4096, RW_KP = 8192, RW_V = 12288, RW_AA = 16384, RW_BB = 20480, RW_GG = 24576, RW_F32_END = 28672;
constexpr int RW_WD_B = RW_F32_END * 4, RW_AD_B = RW_WD_B + 8192, RW_GD_B = RW_AD_B + 8192, RW_BON_B = RW_GD_B + 16384, RW_END_B = RW_BON_B + 256;
static_assert(RW_END_B <= MISC_OFF, "rwkv LDS");

__device__ __forceinline__ void rwkv_prompt_unit(Frame& F, int b, int h) {
    LAS float* L = (LAS float*)F.lds;
    LAS bf16* WD = (LAS bf16*)(F.lds + RW_WD_B); LAS bf16* AD = (LAS bf16*)(F.lds + RW_AD_B); LAS bf16* GD = (LAS bf16*)(F.lds + RW_GD_B);
    LAS float* BON = (LAS float*)(F.lds + RW_BON_B);
    const bf16* cur = (const bf16*)(F.a->ws + WS_CUR); bf16* O = (bf16*)(F.a->ws + WS_O);
    const float* mu = F.a->in[I_MU];
    float S[64];
#pragma unroll
    for (int j = 0; j < 64; ++j) S[j] = 0.f;
    const int t_ = F.tid >> 3, jg = F.tid & 7, hc = 64 * h + 8 * jg;
    for (int ch = 0; ch < SEQ / 64; ++ch) {
        const int t0 = ch * 64;
        for (int it = 0; it < 7; ++it) {
            const int item = it * 512 + F.tid, t = item / 56, vi = item % 56;
            const int col = vi < 8 ? 64 * h + 8 * vi : vi < 16 ? 512 + 64 * h + 8 * (vi - 8) : vi < 24 ? 1024 + 64 * h + 8 * (vi - 16) : 1536 + 8 * (vi - 24);
            const size_t row = (size_t)b * SEQ + t0 + t;
            const v4u c = *(const GAS v4u*)(cur + row * NSHIFT + col);
            v4u p = (v4u){0u, 0u, 0u, 0u};
            if (t0 + t > 0) p = *(const GAS v4u*)(cur + (row - 1) * NSHIFT + col);
            const f32x4 m0 = *(const GAS f32x4*)(mu + col), m1 = *(const GAS f32x4*)(mu + col + 4);
            float x[8];
            { const float c0 = bflo(c.x), c1 = bfhi(c.x), c2 = bflo(c.y), c3 = bfhi(c.y), c4 = bflo(c.z), c5 = bfhi(c.z), c6 = bflo(c.w), c7 = bfhi(c.w);
              x[0] = c0 + m0.x * (bflo(p.x) - c0); x[1] = c1 + m0.y * (bfhi(p.x) - c1); x[2] = c2 + m0.z * (bflo(p.y) - c2); x[3] = c3 + m0.w * (bfhi(p.y) - c3);
              x[4] = c4 + m1.x * (bflo(p.z) - c4); x[5] = c5 + m1.y * (bfhi(p.z) - c5); x[6] = c6 + m1.z * (bflo(p.w) - c6); x[7] = c7 + m1.w * (bfhi(p.w) - c7); }
            if (vi < 24) {
                LAS float* dst = L + (vi < 8 ? RW_R : vi < 16 ? RW_KP : RW_V) + t * 64 + 8 * (vi & 7);
                *(LAS f32x4*)dst = (f32x4){x[0], x[1], x[2], x[3]}; *(LAS f32x4*)(dst + 4) = (f32x4){x[4], x[5], x[6], x[7]};
            } else {
                const int m = 8 * (vi - 24);
                if (m < 64) { _Pragma("unroll") for (int i = 0; i < 8; ++i) x[i] = tanhf_(x[i]); *(LAS v4u*)(WD + t * 64 + m) = (v4u){pk2(x[0], x[1]), pk2(x[2], x[3]), pk2(x[4], x[5]), pk2(x[6], x[7])}; }
                else if (m < 128) { *(LAS v4u*)(AD + t * 64 + (m - 64)) = (v4u){pk2(x[0], x[1]), pk2(x[2], x[3]), pk2(x[4], x[5]), pk2(x[6], x[7])}; }
                else { _Pragma("unroll") for (int i = 0; i < 8; ++i) x[i] = sigmoidf_(x[i]); *(LAS v4u*)(GD + t * 128 + (m - 128)) = (v4u){pk2(x[0], x[1]), pk2(x[2], x[3]), pk2(x[4], x[5]), pk2(x[6], x[7])}; }
            }
        }
        __syncthreads();
        {
            float aw[8], aa[8], ag[8];
            { const f32x4 w0a = *(const GAS f32x4*)(F.a->in[I_W0] + hc), w0b = *(const GAS f32x4*)(F.a->in[I_W0] + hc + 4), a0a = *(const GAS f32x4*)(F.a->in[I_A0] + hc), a0b = *(const GAS f32x4*)(F.a->in[I_A0] + hc + 4);
              aw[0] = w0a.x; aw[1] = w0a.y; aw[2] = w0a.z; aw[3] = w0a.w; aw[4] = w0b.x; aw[5] = w0b.y; aw[6] = w0b.z; aw[7] = w0b.w;
              aa[0] = a0a.x; aa[1] = a0a.y; aa[2] = a0a.z; aa[3] = a0a.w; aa[4] = a0b.x; aa[5] = a0b.y; aa[6] = a0b.z; aa[7] = a0b.w; }
#pragma unroll
            for (int i = 0; i < 8; ++i) ag[i] = 0.f;
            for (int m = 0; m < 64; ++m) {
                const float wd = bf2f(WD[t_ * 64 + m]), ad = bf2f(AD[t_ * 64 + m]);
                const f32x4 w2a = *(const GAS f32x4*)(F.a->in[I_W2] + m * 512 + hc), w2b = *(const GAS f32x4*)(F.a->in[I_W2] + m * 512 + hc + 4);
                const f32x4 a2a = *(const GAS f32x4*)(F.a->in[I_A2] + m * 512 + hc), a2b = *(const GAS f32x4*)(F.a->in[I_A2] + m * 512 + hc + 4);
                aw[0] += wd * w2a.x; aw[1] += wd * w2a.y; aw[2] += wd * w2a.z; aw[3] += wd * w2a.w; aw[4] += wd * w2b.x; aw[5] += wd * w2b.y; aw[6] += wd * w2b.z; aw[7] += wd * w2b.w;
                aa[0] += ad * a2a.x; aa[1] += ad * a2a.y; aa[2] += ad * a2a.z; aa[3] += ad * a2a.w; aa[4] += ad * a2b.x; aa[5] += ad * a2b.y; aa[6] += ad * a2b.z; aa[7] += ad * a2b.w;
            }
            for (int m = 0; m < 128; ++m) {
                const float gd = bf2f(GD[t_ * 128 + m]);
                const f32x4 g2a = *(const GAS f32x4*)(F.a->in[I_G2] + m * 512 + hc), g2b = *(const GAS f32x4*)(F.a->in[I_G2] + m * 512 + hc + 4);
                ag[0] += gd * g2a.x; ag[1] += gd * g2a.y; ag[2] += gd * g2a.z; ag[3] += gd * g2a.w; ag[4] += gd * g2b.x; ag[5] += gd * g2b.y; ag[6] += gd * g2b.z; ag[7] += gd * g2b.w;
            }
            float kkv[8], ss = 0.f, bon = 0.f, kp[8], al[8];
#pragma unroll
            for (int i = 0; i < 8; ++i) {
                const float w = -softplusf_(-aw[i]) - 0.5f;
                L[RW_DEC + t_ * 64 + 8 * jg + i] = __expf(-__expf(w));
                al[i] = sigmoidf_(aa[i]);
                const float k = L[RW_KP + t_ * 64 + 8 * jg + i];
                kkv[i] = k * F.a->in[I_KK][hc + i]; ss += kkv[i] * kkv[i];
                kp[i] = k * (1.0f + (al[i] - 1.0f) * F.a->in[I_KA][hc + i]);
                bon += L[RW_R + t_ * 64 + 8 * jg + i] * kp[i] * F.a->in[I_RK][hc + i];
            }
            ss += __shfl_xor(ss, 1); ss += __shfl_xor(ss, 2); ss += __shfl_xor(ss, 4);
            bon += __shfl_xor(bon, 1); bon += __shfl_xor(bon, 2); bon += __shfl_xor(bon, 4);
            const float inv = 1.0f / fmaxf(sqrtf(ss), 1e-12f);
#pragma unroll
            for (int i = 0; i < 8; ++i) {
                const float kn = kkv[i] * inv;
                L[RW_KP + t_ * 64 + 8 * jg + i] = kp[i]; L[RW_AA + t_ * 64 + 8 * jg + i] = -kn; L[RW_BB + t_ * 64 + 8 * jg + i] = kn * al[i]; L[RW_GG + t_ * 64 + 8 * jg + i] = ag[i];
            }
            if (jg == 0) BON[t_] = bon;
        }
        __syncthreads();
        if (F.wave == 0) {
            for (int t = 0; t < 64; ++t) {
                float sa = 0.f;
#pragma unroll
                for (int j4 = 0; j4 < 16; ++j4) { const f32x4 a = *(const LAS f32x4*)(L + RW_AA + t * 64 + 4 * j4); sa += S[4 * j4] * a.x + S[4 * j4 + 1] * a.y + S[4 * j4 + 2] * a.z + S[4 * j4 + 3] * a.w; }
                const float vv = L[RW_V + t * 64 + F.lane];
                float y = 0.f;
#pragma unroll
                for (int j4 = 0; j4 < 16; ++j4) {
                    const f32x4 d = *(const LAS f32x4*)(L + RW_DEC + t * 64 + 4 * j4), bb = *(const LAS f32x4*)(L + RW_BB + t * 64 + 4 * j4), kk = *(const LAS f32x4*)(L + RW_KP + t * 64 + 4 * j4), rr = *(const LAS f32x4*)(L + RW_R + t * 64 + 4 * j4);
                    S[4 * j4] = S[4 * j4] * d.x + sa * bb.x + vv * kk.x; S[4 * j4 + 1] = S[4 * j4 + 1] * d.y + sa * bb.y + vv * kk.y;
                    S[4 * j4 + 2] = S[4 * j4 + 2] * d.z + sa * bb.z + vv * kk.z; S[4 * j4 + 3] = S[4 * j4 + 3] * d.w + sa * bb.w + vv * kk.w;
                    y += S[4 * j4] * rr.x + S[4 * j4 + 1] * rr.y + S[4 * j4 + 2] * rr.z + S[4 * j4 + 3] * rr.w;
                }
                LDS_WAIT();
                L[RW_R + t * 64 + F.lane] = y;
            }
        }
        __syncthreads();
        {
            float y[8], s = 0.f;
#pragma unroll
            for (int i = 0; i < 8; ++i) { y[i] = L[RW_R + t_ * 64 + 8 * jg + i]; s += y[i]; }
            s += __shfl_xor(s, 1); s += __shfl_xor(s, 2); s += __shfl_xor(s, 4);
            const float mean = s * (1.0f / 64.0f); float q = 0.f;
#pragma unroll
            for (int i = 0; i < 8; ++i) { y[i] -= mean; q += y[i] * y[i]; }
            q += __shfl_xor(q, 1); q += __shfl_xor(q, 2); q += __shfl_xor(q, 4);
            const float rstd = 1.0f / sqrtf(q * (1.0f / 64.0f) + GN_EPS), bon = BON[t_];
            float o[8];
#pragma unroll
            for (int i = 0; i < 8; ++i) o[i] = (y[i] * rstd * F.a->in[I_LNW][hc + i] + F.a->in[I_LNB][hc + i] + bon * L[RW_V + t_ * 64 + 8 * jg + i]) * L[RW_GG + t_ * 64 + 8 * jg + i];
            *(GAS v4u*)(O + ((size_t)b * SEQ + t0 + t_) * 512 + hc) = (v4u){pk2(o[0], o[1]), pk2(o[2], o[3]), pk2(o[4], o[5]), pk2(o[6], o[7])};
        }
        __syncthreads();
    }
    if (F.wave == 0) {
        float* so = F.a->out + O_WKV_P + ((size_t)(b * 8 + h) * 64 + F.lane) * 64;
#pragma unroll
        for (int j4 = 0; j4 < 16; ++j4) *(GAS f32x4*)(so + 4 * j4) = (f32x4){S[4 * j4], S[4 * j4 + 1], S[4 * j4 + 2], S[4 * j4 + 3]};
    }
}
__device__ __forceinline__ void rwkv_sample_unit(Frame& F, int bs) {
    const int h = F.wave, j = F.lane, hc = 64 * h + j;
    LAS float* LX = (LAS float*)F.lds + F.wave * 1024;
    LAS float* VA = LX + 256; LAS float* VB = VA + 64; LAS float* VD = VB + 64; LAS float* VK = VD + 64; LAS float* VR = VK + 64;
    const bf16* cur = (const bf16*)(F.a->ws + WS_CUR) + ((size_t)MP + bs) * NSHIFT; bf16* O = (bf16*)(F.a->ws + WS_O);
    const float* prev = F.a->in[I_SHIFT] + (size_t)bs * NSHIFT; const float* mu = F.a->in[I_MU];
#define MIXC(col) ({ const float c_ = bf2f(cur[(col)]); c_ + mu[(col)] * (prev[(col)] - c_); })
#pragma unroll
    for (int q = 0; q < 4; ++q) { const int m = j + 64 * q; float x = MIXC(1536 + m); x = q == 0 ? tanhf_(x) : (q == 1 ? x : sigmoidf_(x)); LX[m] = x; }
    const float r = MIXC(hc), k = MIXC(512 + hc), v = MIXC(1024 + hc);
#undef MIXC
    LDS_WAIT();
    float aw = F.a->in[I_W0][hc], aa = F.a->in[I_A0][hc], ag = 0.f;
#pragma unroll 16
    for (int m = 0; m < 64; ++m) { aw += LX[m] * F.a->in[I_W2][m * 512 + hc]; aa += LX[64 + m] * F.a->in[I_A2][m * 512 + hc]; }
#pragma unroll 32
    for (int m = 0; m < 128; ++m) ag += LX[128 + m] * F.a->in[I_G2][m * 512 + hc];
    const float w = -softplusf_(-aw) - 0.5f, dec = __expf(-__expf(w)), al = sigmoidf_(aa);
    const float kkv = k * F.a->in[I_KK][hc], nrm = fmaxf(sqrtf(wave_sum(kkv * kkv)), 1e-12f), kn = kkv / nrm;
    const float kp = k * (1.0f + (al - 1.0f) * F.a->in[I_KA][hc]);
    const float bon = wave_sum(r * kp * F.a->in[I_RK][hc]);
    VA[j] = -kn; VB[j] = kn * al; VD[j] = dec; VK[j] = kp; VR[j] = r;
    LDS_WAIT();
    asm volatile("" ::: "memory");
    const float* s0 = F.a->in[I_WKV] + ((size_t)(bs * 8 + h) * 64 + j) * 64;
    float* s1 = F.a->out + O_WKV_S + ((size_t)(bs * 8 + h) * 64 + j) * 64;
    float S[64];
#pragma unroll
    for (int j4 = 0; j4 < 16; ++j4) { const f32x4 t = *(const GAS f32x4*)(s0 + 4 * j4); S[4 * j4] = t.x; S[4 * j4 + 1] = t.y; S[4 * j4 + 2] = t.z; S[4 * j4 + 3] = t.w; }
    float sa = 0.f;
#pragma unroll
    for (int j4 = 0; j4 < 16; ++j4) { const f32x4 a = *(const LAS f32x4*)(VA + 4 * j4); sa += S[4 * j4] * a.x + S[4 * j4 + 1] * a.y + S[4 * j4 + 2] * a.z + S[4 * j4 + 3] * a.w; }
    float y = 0.f;
#pragma unroll
    for (int j4 = 0; j4 < 16; ++j4) {
        const f32x4 d = *(const LAS f32x4*)(VD + 4 * j4), bb = *(const LAS f32x4*)(VB + 4 * j4), kk = *(const LAS f32x4*)(VK + 4 * j4), rr = *(const LAS f32x4*)(VR + 4 * j4);
        S[4 * j4] = S[4 * j4] * d.x + sa * bb.x + v * kk.x; S[4 * j4 + 1] = S[4 * j4 + 1] * d.y + sa * bb.y + v * kk.y;
        S[4 * j4 + 2] = S[4 * j4 + 2] * d.z + sa * bb.z + v * kk.z; S[4 * j4 + 3] = S[4 * j4 + 3] * d.w + sa * bb.w + v * kk.w;
        y += S[4 * j4] * rr.x + S[4 * j4 + 1] * rr.y + S[4 * j4 + 2] * rr.z + S[4 * j4 + 3] * rr.w;
        asm volatile("" ::: "memory");
    }
#pragma unroll
    for (int j4 = 0; j4 < 16; ++j4) *(GAS f32x4*)(s1 + 4 * j4) = (f32x4){S[4 * j4], S[4 * j4 + 1], S[4 * j4 + 2], S[4 * j4 + 3]};
    const float mean = wave_sum(y) * (1.0f / 64.0f), dy = y - mean, var = wave_sum(dy * dy) * (1.0f / 64.0f);
    const float o = (dy * (1.0f / sqrtf(var + GN_EPS)) * F.a->in[I_LNW][hc] + F.a->in[I_LNB][hc] + bon * v) * ag;
    O[((size_t)MP + bs) * OZP + hc] = (bf16)f2bf(o);
    LDS_WAIT();
}
#define MIX_LOOP(lo_, hi_, first_, stride_, call_) _Pragma("unroll 1") for (int u = (lo_) + (first_); u < (hi_); u += (stride_)) { Frame Fu = F; asm volatile("" : "+v"(Fu.tid)); Fu.lane = Fu.tid & 63; call_; __syncthreads(); }
#ifndef PROBE_MIX
#define PROBE_MIX 0
#endif
__device__ __forceinline__ void mixer_phase1(Frame& F) {
    MIX_LOOP(0, 256, F.bid, F.G, rwkvA_unit(Fu, u >> 5, u & 31))
    if (PROBE_MIX == 1) { MIX_LOOP(0, 256, F.bid, F.G, rwkvA_unit(Fu, u >> 5, u & 31)) }
}
__device__ __forceinline__ void mixer_phase2(Frame& F) {
    if (F.G >= 128) {
        if (F.bid < 64) { MIX_LOOP(0, 64, F.bid, 64, rwkvB_unit(Fu, u >> 3, u & 7, (bf16*)(F.a->ws + WS_O), ~(size_t)0))
            if (PROBE_MIX == 5) { MIX_LOOP(0, 64, F.bid, 64, rwkvB_unit(Fu, u >> 3, u & 7, (bf16*)(F.a->ws + WS_BON + 1 * MiB), (size_t)2047)) } }
        else {
            MIX_LOOP(0, 256, F.bid - 64, F.G - 64, s5_prompt_unit2(Fu, u >> 5, u & 31))
            MIX_LOOP(0, 128, F.G - 1 - F.bid, F.G - 64, s5_sample_unit(Fu, u)) MIX_LOOP(0, 128, F.G - 1 - F.bid, F.G - 64, rwkv_sample_unit(Fu, u))
            if (PROBE_MIX == 2) { MIX_LOOP(0, 256, F.bid - 64, F.G - 64, s5_prompt_unit2(Fu, u >> 5, u & 31)) }
        }
    } else {
        MIX_LOOP(0, 64, F.bid, F.G, rwkvB_unit(Fu, u >> 3, u & 7, (bf16*)(F.a->ws + WS_O), ~(size_t)0)) MIX_LOOP(0, 256, F.bid, F.G, s5_prompt_unit2(Fu, u >> 5, u & 31))
        MIX_LOOP(0, 128, F.bid, F.G, s5_sample_unit(Fu, u)) MIX_LOOP(0, 128, F.bid, F.G, rwkv_sample_unit(Fu, u))
    }
    const bf16* cur = (const bf16*)(F.a->ws + WS_CUR);
    for (int i = F.bid * 512 + F.tid; i < NB * NSHIFT; i += F.G * 512) {
        const int b = i / NSHIFT, c = i % NSHIFT;
        if (b < 8) F.a->out[O_SHIFT_P + (size_t)b * NSHIFT + c] = bf2f(cur[((size_t)b * SEQ + SEQ - 1) * NSHIFT + c]);
        else F.a->out[O_SHIFT_S + (size_t)(b - 8) * NSHIFT + c] = bf2f(cur[((size_t)MP + (b - 8)) * NSHIFT + c]);
    }
}
#undef MIX_LOOP

#ifndef MK_N_LAUNCHES
#define MK_N_LAUNCHES 1
#endif
constexpr int N_PHASES = 14;

__global__ void __launch_bounds__(NWAVES * 64, 2) fwd_kernel(Args args) {
    extern __shared__ __attribute__((aligned(16))) unsigned char lds[];
    Frame F;
    F.lds = (LAS unsigned char*)lds;
    F.tid = threadIdx.x; F.lane = F.tid & 63; F.wave = __builtin_amdgcn_readfirstlane(F.tid >> 6);
    F.G = gridDim.x; F.bid = blockIdx.x;
    F.a = &args;
    unsigned char* ws = args.ws;
    volatile LAS unsigned* MISC = (volatile LAS unsigned*)(F.lds + MISC_OFF);
    if (F.tid < 64) MISC[F.tid] = 0u;
    __syncthreads();
    XcdBarrier bar; bar.bar = (unsigned*)(ws + WS_CTL) + 4096; bar.x = 0; bar.st = nullptr;
    const int lo = args.ph_lo, hi = args.ph_hi;
    if (hi - lo > 1) bar = xcd_barrier_post((unsigned*)(ws + WS_CTL) + 4096, MISC + 8);
#ifndef PHASE_MASK
#define PHASE_MASK 0xFFFFF
#endif
#define IN(k) (((PHASE_MASK >> (k)) & 1) && lo <= (k) && (k) < hi)
#ifndef BAR_IMPL
#define BAR_IMPL xcd_barrier3
#endif
#define SEAM(k) do { if (IN(k) && IN((k) + 1)) BAR_IMPL(bar); } while (0)
#ifndef PROBE_DUP
#define PROBE_DUP -1
#endif
#define RUN(k, ...) if (IN(k)) { __VA_ARGS__ if (PROBE_DUP == (k)) { BAR_IMPL(bar); __VA_ARGS__ } } SEAM(k);
    const float* mod = (const float*)(ws + WS_MOD);
    float* H = F.a->out + O_Y;
    bf16* HB = (bf16*)H + 1024;
    bf16* XN = (bf16*)(ws + WS_XN);
    bf16* HID = (bf16*)(ws + WS_BIG);
    float* SLAB = (float*)(ws + WS_SLAB);
    bf16* MM = (bf16*)(ws + WS_S5IN);
    const int bid = (int)blockIdx.x;

    RUN(0, p0_prologue(F, 0, 0); s5_par_prologue(F);)
#ifdef PROBE_S5PAR
    if (IN(0)) { s5_par_prologue(F); BAR_IMPL(bar); }
#endif
    RUN(1, pg8::Gemm g{{(const bf16*)(ws + WS_SC)}, {(const bf16*)(ws + WS_WADA)}, 256, NMOD, D, D}; pg8::StaticOrder S; S.init(256, NMOD, F.G, bid);
        pg8::EpiMod E{(float*)(ws + WS_MOD), F.a->in[I_BADA]};
        pg8::gemm_phase<pg8::EpiMod, pg8::StaticOrder, true, true>(F.lds, g, S, E);
        __syncthreads(); p0_prologue(F, 1, F.G >= 72 ? 36 : 0);)
#ifdef PROBE_P1
#if PROBE_P1 == 3
    if (IN(1)) { pg8::Gemm g{{(const bf16*)(ws + WS_SC)}, {(const bf16*)(ws + WS_WADA)}, 256, NMOD, D, D}; pg8::StaticOrder S; S.init(256, NMOD, F.G, bid);
        pg8::EpiMod E{(float*)(ws + WS_MOD), F.a->in[I_BADA]};
        pg8::gemm_phase<pg8::EpiMod, pg8::StaticOrder, true, true>(F.lds, g, S, E); BAR_IMPL(bar); }
#else
    if (IN(1)) { p0_prologue(F, 1, PROBE_P1 == 1 ? 36 : 0); BAR_IMPL(bar); }
#endif
#endif
#ifdef PROBE_BAR
#if PROBE_BAR == 1
    for (int i_ = 0; i_ < 8; ++i_) xcd_barrier(bar);
#elif PROBE_BAR == 4
    for (int i_ = 0; i_ < 8; ++i_) xcd_barrier2(bar);
#else
    for (int i_ = 0; i_ < 8; ++i_) {
        unsigned* ctr = (unsigned*)(ws + WS_CTL) + 8192;
        asm volatile("s_waitcnt vmcnt(0)" ::: "memory"); __syncthreads();
        if (threadIdx.x == 0) {
#if PROBE_BAR != 3
            __builtin_amdgcn_fence(__ATOMIC_RELEASE, "agent"); asm volatile("s_waitcnt vmcnt(0)" ::: "memory");
#endif
            __hip_atomic_fetch_add(ctr, 1u, __ATOMIC_RELAXED, __HIP_MEMORY_SCOPE_AGENT);
            const unsigned target = (unsigned)(i_ + 1) * gridDim.x; unsigned sp = 0;
            while (__hip_atomic_load(ctr, __ATOMIC_RELAXED, __HIP_MEMORY_SCOPE_AGENT) < target) { __builtin_amdgcn_s_sleep(1); if (++sp > (1u << 20)) break; }
#if PROBE_BAR != 3
            __builtin_amdgcn_fence(__ATOMIC_ACQUIRE, "agent"); asm volatile("s_waitcnt vmcnt(0)" ::: "memory");
#endif
        }
        __syncthreads();
    }
#endif
#endif
    RUN(2, norm_phase<false, true>(F, F.a->in[I_XP], F.a->in[I_XS], HB, F.a->in[I_GFFN1], 0, 1, XN, nullptr, nullptr, 0);)
    RUN(3, pg8::Gemm g{{XN}, {(const bf16*)(ws + WS_W13_1)}, MPAD, 2 * DFF, D, D}; pg8::StaticOrder S; S.init(MPAD, 2 * DFF, F.G, bid);
        pg8::EpiSwiglu E{HID, DFF};
        pg8::gemm_phase<pg8::EpiSwiglu, pg8::StaticOrder, true, true>(F.lds, g, S, E);)
    RUN(4, pg8::Gemm g{{HID}, {(const bf16*)(ws + WS_W2_1)}, MPAD, D, DFF, DFF}; pg8::MainPlusSlice S; S.init3(MP, D, F.G, bid, DFF / 256, MP / 256, 256);
        pg8::EpiResSlab E{{F.a->in[I_XP], F.a->in[I_XS], HB, mod, 2, 0.5f}, {SLAB, mod, 2, 0.5f, 256}};
        pg8::gemm_phase<pg8::EpiResSlab, pg8::MainPlusSlice, true, true>(F.lds, g, S, E);)
    RUN(5, norm_phase<false, false>(F, nullptr, nullptr, HB, F.a->in[I_GMIX], 3, 4, XN, nullptr, SLAB, DFF / 256);)
    RUN(6, pg8::Gemm g{{XN}, {(const bf16*)(ws + WS_WIN)}, MPAD, NIN, D, D}; pg8::ExtOrder S; S.init2(MPAD, 2304, F.G, bid, 8, MP / 256, 9);
        pg8::EpiWin E{(bf16*)(ws + WS_S5IN), (bf16*)(ws + WS_CUR), (bf16*)(ws + WS_GATES), 0};
        pg8::gemm_phase<pg8::EpiWin, pg8::ExtOrder, true, true>(F.lds, g, S, E);)
    RUN(7, mixer_phase1(F);)
    RUN(8, mixer_phase2(F);)
    RUN(9, for (int s_ = bid; s_ < 256; s_ += F.G) sample_mix_unit(F, s_);
        pg8::Gemm g{{XN, (const bf16*)(ws + WS_OZ), (const bf16*)(ws + WS_OZ)}, {(const bf16*)(ws + WS_WIN), (const bf16*)(ws + WS_GPT), (const bf16*)(ws + WS_GPT)}, MPAD, 0, D, D};
        pg8::ChainOrder S; S.init(F.G, bid, MP / 256);
        pg8::EpiChain E{{(bf16*)(ws + WS_S5IN), (bf16*)(ws + WS_CUR), (bf16*)(ws + WS_GATES), 0}, {(const bf16*)(ws + WS_GATES), MM}, {(const bf16*)(ws + WS_GATES), MM, MM}};
        pg8::gemm_phase<pg8::EpiChain, pg8::ChainOrder, true, true>(F.lds, g, S, E);)
    RUN(10, pg8::Gemm g{{MM}, {(const bf16*)(ws + WS_WOUT)}, MPAD, D, D, D}; pg8::MainPlusSlice S; S.init3(MP, D, F.G, bid, D / 256, MP / 256, 256);
        pg8::EpiResSlab E{{nullptr, nullptr, HB, mod, 5, 1.0f}, {SLAB, mod, 5, 1.0f, 256}};
        pg8::gemm_phase<pg8::EpiResSlab, pg8::MainPlusSlice, true, true>(F.lds, g, S, E);)
    RUN(11, norm_phase<false, false>(F, nullptr, nullptr, HB, F.a->in[I_GFFN2], 6, 7, XN, nullptr, SLAB, D / 256);)
    RUN(12, pg8::Gemm g{{XN}, {(const bf16*)(ws + WS_W13_2)}, MPAD, 2 * DFF, D, D}; pg8::StaticOrder S; S.init(MPAD, 2 * DFF, F.G, bid);
        pg8::EpiSwiglu E{HID, DFF};
        pg8::gemm_phase<pg8::EpiSwiglu, pg8::StaticOrder, true, true>(F.lds, g, S, E);)
    RUN(13, pg8::Gemm g{{HID}, {(const bf16*)(ws + WS_W2_2)}, MPAD, D, DFF, DFF}; pg8::MainPlusSlice S; S.init3(MP, D, F.G, bid, DFF / 256, MP / 256, 256);
        pg8::EpiResSlab E{{nullptr, nullptr, HB, mod, 8, 0.5f}, {SLAB, mod, 8, 0.5f, 256}};
        pg8::gemm_phase<pg8::EpiResSlab, pg8::MainPlusSlice, true, true>(F.lds, g, S, E);)
    if (IN(14)) { norm_phase<true, false>(F, nullptr, nullptr, HB, F.a->in[I_GFINAL], 0, 0, nullptr, H, SLAB, DFF / 256); }
#undef IN
#undef SEAM
}

extern "C" void kernel_launch(void* const* d_in, const int* in_sizes, int n_in, void* d_out, int out_size, void* d_ws, size_t ws_size, hipStream_t stream) {
    static int grid = 0;
    if (grid == 0) {
        if (n_in != N_IN_T || (size_t)out_size != O_TOTAL || ws_size < WS_END) { fprintf(stderr, "kernel_launch: unexpected shapes: n_in %d out %d ws %zu\n", n_in, out_size, ws_size); grid = -1; return; }
        int dev = 0, cus = 0, per_cu = 0;
        if (hipGetDevice(&dev) != hipSuccess || hipDeviceGetAttribute(&cus, hipDeviceAttributeMultiprocessorCount, dev) != hipSuccess) { grid = -1; return; }
        if (hipFuncSetAttribute((const void*)fwd_kernel, hipFuncAttributeMaxDynamicSharedMemorySize, LDS_BYTES) != hipSuccess) { fprintf(stderr, "kernel_launch: hipFuncSetAttribute failed\n"); grid = -1; return; }
        if (hipOccupancyMaxActiveBlocksPerMultiprocessor(&per_cu, (const void*)fwd_kernel, NWAVES * 64, LDS_BYTES) != hipSuccess || per_cu < 1) { fprintf(stderr, "kernel_launch: occupancy query says %d\n", per_cu); per_cu = 1; }
        (void)hipGetLastError();
        grid = cus;
    }
    if (grid < 0) return;
    (void)hipMemsetAsync((char*)d_ws + WS_CTL, 0, CTL_ZERO_BYTES, stream);
    Args a{};
    for (int i = 0; i < N_IN_T; ++i) a.in[i] = (const float*)d_in[i];
    a.out = (float*)d_out; a.ws = (unsigned char*)d_ws;
#if MK_N_LAUNCHES == 1
    a.ph_lo = 0; a.ph_hi = N_PHASES + 1;
    void* kargs[] = {&a};
    hipError_t e = hipLaunchCooperativeKernel((const void*)fwd_kernel, dim3(grid), dim3(NWAVES * 64), kargs, LDS_BYTES, stream);
    if (e != hipSuccess) fprintf(stderr, "kernel_launch: cooperative launch failed: %s\n", hipGetErrorString(e));
#else
    for (int p = 0; p <= N_PHASES; ++p) { a.ph_lo = p; a.ph_hi = p + 1; hipLaunchKernelGGL(fwd_kernel, dim3(grid), dim3(NWAVES * 64), LDS_BYTES, stream, a); }
#endif
}
```

```cpp
#include <hip/hip_runtime.h>
#include <cstdio>
#include <cstdint>
namespace pg8 {
#define PG8_LAS __attribute__((address_space(3)))
typedef unsigned short bf16_t;
typedef short bf16x8 __attribute__((ext_vector_type(8)));
typedef float f32x4 __attribute__((ext_vector_type(4)));
typedef unsigned u32x4 __attribute__((ext_vector_type(4)));
typedef int v4i32 __attribute__((ext_vector_type(4)));
typedef int v8i32 __attribute__((ext_vector_type(8)));
typedef unsigned u32x2 __attribute__((ext_vector_type(2)));
constexpr int BM = 256, BK = 64, HALF = 128, HTB = HALF * BK * 2  , STAGE_BYTES = 8 * HTB, NXCD = 8, WGM = 8;

__host__ __device__ __forceinline__ int lds_byte(int r, int c) { const int st = (r >> 4) * 2 + (c >> 5), rr = r & 15, cc = c & 31, ob = rr * 64 + cc * 2; return st * 1024 + (ob ^ (((ob >> 9) & 1) << 5)); }
__host__ __device__ __forceinline__ void stage_rc(int b, int& R, int& C) { const int st = b / 1024, sb = b % 1024, swz = sb ^ (((sb >> 9) & 1) << 5); R = (st >> 1) * 16 + swz / 64; C = (st & 1) * 32 + (swz % 64) / 2; }
__host__ __device__ __forceinline__ int perm32(int rho) { const int n = rho >> 4, i = rho & 15; return 8 * (i >> 2) + 4 * n + (i & 3); }

struct Unit { int pm, pn, ko, nt, kind; };
struct Gemm { const bf16_t* A[3]; const bf16_t* Bt[3]; int M, N, K, ld, ld1, ld0; };

struct StaticOrder {
    int nM, nN, nwg, G, c;
    __host__ __device__ void init(int M, int N, int G_, int c_) { nM = M / BM; nN = N / BM; nwg = nM * nN; G = G_; c = c_; }
    __host__ __device__ bool next(int i, Unit& u) const {
        const long L = (long)i * G + c; if (L >= nwg) return false;
        int wgid = (int)L; { const int q = nwg / NXCD, r = nwg % NXCD, xcd = wgid % NXCD, off = wgid / NXCD; wgid = (xcd < r ? xcd * (q + 1) : r * (q + 1) + (xcd - r) * q) + off; }
        const int nig = WGM * nN, gid = wgid / nig, fm = gid * WGM, gsz = (nM - fm) < WGM ? (nM - fm) : WGM;
        u.pm = fm + ((wgid % nig) % gsz); u.pn = (wgid % nig) / gsz; u.ko = 0; u.nt = 0; u.kind = 0; return true;
    }
    __device__ __forceinline__ void a_ready(const Unit&) const {}
    __device__ __forceinline__ void done(const Unit&) const {}
};


struct ExtOrder : StaticOrder {
    int base_nwg, extra, xm, xn0;
    __host__ __device__ void init2(int M, int N, int G_, int c_, int extra_, int xm_, int xn0_) { init(M, N, G_, c_); base_nwg = nwg; extra = extra_; xm = xm_; xn0 = xn0_; }
    __host__ __device__ bool next(int i, Unit& u) const {
        const long L = (long)i * G + c;
        if (L < base_nwg) return StaticOrder::next(i, u);
        if (L >= base_nwg + extra) return false;
        u.pm = xm; u.pn = xn0 + (int)(L - base_nwg); u.ko = 0; u.nt = 0; u.kind = 0; return true;
    }
};
struct SliceOrder {
    int nN, nsub, G, c, pm, ks;
    __host__ __device__ void init(int nN_, int nslices, int G_, int c_, int pm_, int ks_) { nN = nN_; nsub = nN_ * nslices; G = G_; c = c_; pm = pm_; ks = ks_; }
    __host__ __device__ bool next(int i, Unit& u) const {
        const int s = G - 1 - c + i * G; if (s >= nsub || s < 0) return false;
        u.pm = pm; u.pn = s % nN; u.ko = (s / nN) * ks; u.nt = ks / BK; u.kind = 0; return true;
    }
    __device__ __forceinline__ void a_ready(const Unit&) const {}
    __device__ __forceinline__ void done(const Unit&) const {}
};

struct MainPlusSlice : StaticOrder {
    SliceOrder sl;
    __host__ __device__ void init3(int M, int N, int G_, int c_, int nslices, int pm_, int ks_) { init(M, N, G_, c_); sl.init(N / BM, nslices, G_, c_, pm_, ks_); }
    __host__ __device__ bool next(int i, Unit& u) const {
        if (i == 0) { if (StaticOrder::next(0, u)) return true; return sl.next(0, u); }
        if (i == 1 && c < nwg) return sl.next(0, u);
        return false;
    }
};

struct ChainOrder {
    int G, c, xm, mode = 0;
    __host__ __device__ void init(int G_, int c_, int xm_, int mode_ = 0) { G = G_; c = c_; xm = xm_; mode = mode_; }
    __host__ __device__ bool next(int i, Unit& u) const {
        const int x = c % NXCD, j = c / NXCD;
        int pm = x * (G / NXCD / 4) + (j >> 2), q = j & 3, k = i;
        if (mode == 1) { if (i >= 2) return false; k = 2 * i; } else if (mode == 2) { if (i >= 3) return false; k = i == 0 ? 1 : i + 2; }
        if (k >= 5) return false;
        u.pm = pm; u.ko = 0;
        if (k == 0) { u.kind = 0; u.pn = 9 + 4 + q; u.nt = 8; }
        else if (k == 1) { u.kind = 1; u.pn = q; u.nt = 8; u.ko = 512; }
        else if (k == 2) { u.kind = 0; u.pn = 9 + q; u.nt = 8; }
        else { u.kind = 2; u.pn = 2 * q + (k - 3); u.nt = 8; }
        return true;
    }
    __device__ __forceinline__ void a_ready(const Unit&) const {}
    __device__ __forceinline__ void done(const Unit&) const {}
};
typedef float f32x2n __attribute__((ext_vector_type(2)));
typedef __bf16 bf16x2n __attribute__((ext_vector_type(2)));
__device__ __forceinline__ unsigned cvt_pk_bf16(float lo, float hi) { const f32x2n v = {lo, hi}; return __builtin_bit_cast(unsigned, __builtin_convertvector(v, bf16x2n)); }
__device__ __forceinline__ float bflo(unsigned w) { return __uint_as_float(w << 16); }
__device__ __forceinline__ float bfhi(unsigned w) { return __uint_as_float(w & 0xffff0000u); }
__device__ __forceinline__ float fsigmoid(float x) { return __builtin_amdgcn_rcpf(1.0f + __expf(-x)); }
constexpr int E_MP = 16384, E_M = 16512, E_NB = 136, E_NMOD = 9216;
__device__ __forceinline__ int row_batch(int r) { int b = r < E_MP ? (r >> 11) : 8 + (r - E_MP); return b < E_NB ? b : E_NB - 1; }

struct EpiMod {
    static constexpr bool PERM = false, AFTER_DRAIN = false;
    float* out; const float* bias;
    __device__ __forceinline__ void operator()(const f32x4 (&acc)[2][2][4][2], const Unit& u, int wr, int wc, int fr, int fq) const {
        const int row0 = u.pm * BM + wr * 64 + fr, col0 = u.pn * BM + wc * 32 + 4 * fq;
#pragma unroll
        for (int ai = 0; ai < 2; ++ai)
#pragma unroll
            for (int m = 0; m < 4; ++m) { const int row = row0 + ai * HALF + m * 16;
                if (row < E_NB) {
#pragma unroll
                    for (int bj = 0; bj < 2; ++bj)
#pragma unroll
                        for (int n = 0; n < 2; ++n) { const int col = col0 + bj * HALF + n * 16; const f32x4 bv = *(const f32x4*)(bias + col);
                            *(f32x4*)(out + (size_t)row * E_NMOD + col) = acc[ai][bj][m][n] + bv; } } }
    }
};
struct EpiSwiglu {
    static constexpr bool PERM = true, AFTER_DRAIN = false;
    bf16_t* O; int ldc;
    __device__ __forceinline__ void operator()(const f32x4 (&acc)[2][2][4][2], const Unit& u, int wr, int wc, int fr, int fq) const {
        const int row0 = u.pm * BM + wr * 64 + fr, col0 = u.pn * HALF + wc * 32 + 8 * fq;
#pragma unroll
        for (int ai = 0; ai < 2; ++ai)
#pragma unroll
            for (int m = 0; m < 4; ++m) { bf16_t* rowp = O + (size_t)(row0 + ai * HALF + m * 16) * ldc + col0;
                float o[8];
#pragma unroll
                for (int n = 0; n < 2; ++n)
#pragma unroll
                    for (int i = 0; i < 4; ++i) { const float a = acc[ai][0][m][n][i], g = acc[ai][1][m][n][i]; o[4 * n + i] = a * fsigmoid(a) * g; }
                u32x4 w; w.x = cvt_pk_bf16(o[0], o[1]); w.y = cvt_pk_bf16(o[2], o[3]); w.z = cvt_pk_bf16(o[4], o[5]); w.w = cvt_pk_bf16(o[6], o[7]);
#ifdef NT_STORES
                __builtin_nontemporal_store(w, (u32x4*)rowp);
#else
                *(u32x4*)rowp = w;
#endif
                }
    }
};
__device__ __forceinline__ unsigned cvt4_fp8(float a, float b, float c, float d) {
    a = __builtin_amdgcn_fmed3f(a, -448.f, 448.f); b = __builtin_amdgcn_fmed3f(b, -448.f, 448.f); c = __builtin_amdgcn_fmed3f(c, -448.f, 448.f); d = __builtin_amdgcn_fmed3f(d, -448.f, 448.f);
    int w = 0; w = __builtin_amdgcn_cvt_pk_fp8_f32(a, b, w, false); w = __builtin_amdgcn_cvt_pk_fp8_f32(c, d, w, true); return (unsigned)w;
}
constexpr float F8_SX = 16.f, F8_SH = 8.f, F8_SW13 = 32.f, F8_SW2 = 64.f, F8_INV_UP = 1.f / (16.f * 32.f), F8_INV_DN = 1.f / (8.f * 64.f);
struct EpiSwiglu8 {
    static constexpr bool PERM = true, AFTER_DRAIN = false;
    unsigned char* O; int ldc;
    __device__ __forceinline__ void operator()(const f32x4 (&acc)[2][2][4][2], const Unit& u, int wr, int wc, int fr, int fq) const {
        const int row0 = u.pm * BM + wr * 64 + fr, col0 = u.pn * HALF + wc * 32 + 8 * fq;
#pragma unroll
        for (int ai = 0; ai < 2; ++ai)
#pragma unroll
            for (int m = 0; m < 4; ++m) { unsigned char* rowp = O + (size_t)(row0 + ai * HALF + m * 16) * ldc + col0;
                float o[8];
#pragma unroll
                for (int n = 0; n < 2; ++n)
#pragma unroll
                    for (int i = 0; i < 4; ++i) { const float a = acc[ai][0][m][n][i], g = acc[ai][1][m][n][i];
                        o[4 * n + i] = (a * g) * (__builtin_amdgcn_rcpf(1.0f + __builtin_amdgcn_exp2f(a * (-1.4426950408889634f * F8_INV_UP))) * (F8_INV_UP * F8_INV_UP * F8_SH)); }
                *(u32x2*)rowp = (u32x2){cvt4_fp8(o[0], o[1], o[2], o[3]), cvt4_fp8(o[4], o[5], o[6], o[7])}; }
    }
};
constexpr int E_HP = 2048;
struct EpiRes {
    static constexpr bool PERM = true, AFTER_DRAIN = false;
    const float* base_p; const float* base_s; bf16_t* hb; const float* mod; int gidx; float scale;
    __device__ __forceinline__ void operator()(const f32x4 (&acc)[2][2][4][2], const Unit& u, int wr, int wc, int fr, int fq) const {
        const int row0 = u.pm * BM + wr * 64 + fr, col0 = u.pn * BM + wc * 32 + 8 * fq;
        const float* gp = mod + (size_t)((u.pm * BM) >> 11) * E_NMOD + gidx * 1024 + col0;
        f32x4 g[2][2];
#pragma unroll
        for (int bj = 0; bj < 2; ++bj) { g[bj][0] = *(const f32x4*)(gp + bj * HALF) * scale; g[bj][1] = *(const f32x4*)(gp + bj * HALF + 4) * scale; }
#pragma unroll
        for (int ai = 0; ai < 2; ++ai) {
            f32x4 b[4][2][2];
            if (base_p) {
#pragma unroll
                for (int m = 0; m < 4; ++m)
#pragma unroll
                    for (int bj = 0; bj < 2; ++bj) { const float* bp = base_p + (size_t)(row0 + ai * HALF + m * 16) * 1024 + col0 + bj * HALF; b[m][bj][0] = *(const f32x4*)bp; b[m][bj][1] = *(const f32x4*)(bp + 4); }
            } else {
                u32x4 h[4][2];
#pragma unroll
                for (int m = 0; m < 4; ++m)
#pragma unroll
                    for (int bj = 0; bj < 2; ++bj) h[m][bj] = *(const u32x4*)(hb + (size_t)(row0 + ai * HALF + m * 16) * E_HP + col0 + bj * HALF);
#pragma unroll
                for (int m = 0; m < 4; ++m)
#pragma unroll
                    for (int bj = 0; bj < 2; ++bj) { const u32x4 x = h[m][bj]; b[m][bj][0] = (f32x4){bflo(x.x), bfhi(x.x), bflo(x.y), bfhi(x.y)}; b[m][bj][1] = (f32x4){bflo(x.z), bfhi(x.z), bflo(x.w), bfhi(x.w)}; }
            }
#pragma unroll
            for (int m = 0; m < 4; ++m)
#pragma unroll
                for (int bj = 0; bj < 2; ++bj) {
                    const f32x4 o0 = b[m][bj][0] + g[bj][0] * acc[ai][bj][m][0], o1 = b[m][bj][1] + g[bj][1] * acc[ai][bj][m][1];
                    u32x4 w; w.x = cvt_pk_bf16(o0[0], o0[1]); w.y = cvt_pk_bf16(o0[2], o0[3]); w.z = cvt_pk_bf16(o1[0], o1[1]); w.w = cvt_pk_bf16(o1[2], o1[3]);
                    *(u32x4*)(hb + (size_t)(row0 + ai * HALF + m * 16) * E_HP + col0 + bj * HALF) = w; }
        }
    }
};
struct EpiWin {
    static constexpr bool PERM = true, AFTER_DRAIN = false;
    bf16_t* s5in; bf16_t* cur; bf16_t* gates; int pn_off;
    float sgs = 1.0f;
    __device__ __forceinline__ void operator()(const f32x4 (&acc)[2][2][4][2], const Unit& u, int wr, int wc, int fr, int fq) const {
        bf16_t* base; int ld, colt; bool sg = false;
        const int pn = u.pn + pn_off;
        if (pn < 2) { base = s5in; ld = 512; colt = pn * BM; } else if (pn < 9) { base = cur; ld = 1792; colt = (pn - 2) * BM; } else { base = gates; ld = 2048; colt = (pn - 9) * BM; sg = true; }
        const int row0 = u.pm * BM + wr * 64 + fr, col0 = colt + wc * 32 + 8 * fq;
#pragma unroll
        for (int ai = 0; ai < 2; ++ai)
#pragma unroll
            for (int m = 0; m < 4; ++m) { bf16_t* rowp = base + (size_t)(row0 + ai * HALF + m * 16) * ld + col0;
#pragma unroll
                for (int bj = 0; bj < 2; ++bj) { f32x4 v0 = acc[ai][bj][m][0], v1 = acc[ai][bj][m][1];
                    if (sg) {
#pragma unroll
                        for (int i = 0; i < 4; ++i) { v0[i] = fsigmoid(v0[i] * sgs); v1[i] = fsigmoid(v1[i] * sgs); } }
                    u32x4 w; w.x = cvt_pk_bf16(v0[0], v0[1]); w.y = cvt_pk_bf16(v0[2], v0[3]); w.z = cvt_pk_bf16(v1[0], v1[1]); w.w = cvt_pk_bf16(v1[2], v1[3]);
                    *(u32x4*)(rowp + bj * HALF) = w; } }
    }
};
struct EpiYr {
    static constexpr bool PERM = true, AFTER_DRAIN = false;
    const bf16_t* gates; bf16_t* mixp;
    __device__ __forceinline__ void operator()(const f32x4 (&acc)[2][2][4][2], const Unit& u, int wr, int wc, int fr, int fq) const {
        const int row0 = u.pm * BM + wr * 64 + fr, col0 = u.pn * BM + wc * 32 + 8 * fq;
        u32x4 g[2][4][2];
#pragma unroll
        for (int ai = 0; ai < 2; ++ai)
#pragma unroll
            for (int m = 0; m < 4; ++m)
#pragma unroll
                for (int bj = 0; bj < 2; ++bj) g[ai][m][bj] = *(const u32x4*)(gates + (size_t)(row0 + ai * HALF + m * 16) * 2048 + 1024 + col0 + bj * HALF);
#pragma unroll
        for (int ai = 0; ai < 2; ++ai)
#pragma unroll
            for (int m = 0; m < 4; ++m) { const size_t row = (size_t)(row0 + ai * HALF + m * 16);
#pragma unroll
                for (int bj = 0; bj < 2; ++bj) { const int col = col0 + bj * HALF; const u32x4 gg = g[ai][m][bj];
                    const f32x4 v0 = acc[ai][bj][m][0], v1 = acc[ai][bj][m][1];
                    u32x4 w; w.x = cvt_pk_bf16(v0[0] * bflo(gg.x), v0[1] * bfhi(gg.x)); w.y = cvt_pk_bf16(v0[2] * bflo(gg.y), v0[3] * bfhi(gg.y));
                    w.z = cvt_pk_bf16(v1[0] * bflo(gg.z), v1[1] * bfhi(gg.z)); w.w = cvt_pk_bf16(v1[2] * bflo(gg.w), v1[3] * bfhi(gg.w));
                    *(u32x4*)(mixp + row * 1024 + col) = w; } }
    }
};
struct EpiGlu {
    static constexpr bool PERM = true, AFTER_DRAIN = false;
    const bf16_t* gates; const bf16_t* mixp; bf16_t* mm; unsigned char* mm8 = nullptr;
    __device__ __forceinline__ void operator()(const f32x4 (&acc)[2][2][4][2], const Unit& u, int wr, int wc, int fr, int fq) const {
        const int row0 = u.pm * BM + wr * 64 + fr, col = u.pn * HALF + wc * 32 + 8 * fq;
        u32x4 g[2][4], p[2][4];
#pragma unroll
        for (int ai = 0; ai < 2; ++ai)
#pragma unroll
            for (int m = 0; m < 4; ++m) { const size_t row = (size_t)(row0 + ai * HALF + m * 16); g[ai][m] = *(const u32x4*)(gates + row * 2048 + col); p[ai][m] = *(const u32x4*)(mixp + row * 1024 + col); }
#pragma unroll
        for (int ai = 0; ai < 2; ++ai)
#pragma unroll
            for (int m = 0; m < 4; ++m) { const size_t row = (size_t)(row0 + ai * HALF + m * 16);
                const u32x4 gg = g[ai][m], pp = p[ai][m];
                float o[8];
#pragma unroll
                for (int n = 0; n < 2; ++n)
#pragma unroll
                    for (int i = 0; i < 4; ++i) o[4 * n + i] = acc[ai][0][m][n][i] * fsigmoid(acc[ai][1][m][n][i]);
                u32x4 w; w.x = cvt_pk_bf16(o[0] * bflo(gg.x) + bflo(pp.x), o[1] * bfhi(gg.x) + bfhi(pp.x)); w.y = cvt_pk_bf16(o[2] * bflo(gg.y) + bflo(pp.y), o[3] * bfhi(gg.y) + bfhi(pp.y));
                w.z = cvt_pk_bf16(o[4] * bflo(gg.z) + bflo(pp.z), o[5] * bfhi(gg.z) + bfhi(pp.z)); w.w = cvt_pk_bf16(o[6] * bflo(gg.w) + bflo(pp.w), o[7] * bfhi(gg.w) + bfhi(pp.w));
                if (mm8) { const float q = F8_SX;
                    *(u32x2*)(mm8 + row * 4096 + col) = (u32x2){cvt4_fp8(q * (o[0] * bflo(gg.x) + bflo(pp.x)), q * (o[1] * bfhi(gg.x) + bfhi(pp.x)), q * (o[2] * bflo(gg.y) + bflo(pp.y)), q * (o[3] * bfhi(gg.y) + bfhi(pp.y))),
                                                                  cvt4_fp8(q * (o[4] * bflo(gg.z) + bflo(pp.z)), q * (o[5] * bfhi(gg.z) + bfhi(pp.z)), q * (o[6] * bflo(gg.w) + bflo(pp.w)), q * (o[7] * bfhi(gg.w) + bfhi(pp.w)))}; }
                else *(u32x4*)(mm + row * 1024 + col) = w; }
    }
};

__device__ __forceinline__ float rows_sum4(float x) {
    float a = x, b = x;
    asm volatile("s_nop 1\n\tv_permlane16_swap_b32 %0, %1\n\ts_nop 1" : "+v"(a), "+v"(b));
    a += b; b = a;
    asm volatile("s_nop 1\n\tv_permlane32_swap_b32 %0, %1\n\ts_nop 1" : "+v"(a), "+v"(b));
    return a + b;
}
constexpr float E_NORM_EPS = 1e-6f;
template <bool FIN>
struct EpiResNormT {
    static constexpr bool PERM = true, AFTER_DRAIN = true;
    const float* base_p; bf16_t* hb; const float* mod; int gidx; float scale;
    float* rowss; unsigned* flag; const float* gn; int sh_idx, sc_idx; bf16_t* xn; float* y; bool xn8 = false; unsigned char* xc = nullptr;
    __device__ __forceinline__ void operator()(const f32x4 (&)[2][2][4][2], const Unit&, int, int, int, int) const {}
    __device__ __forceinline__ void fused(f32x4 (&acc)[2][2][4][2], const Unit& u, int wr, int wc, int fr, int fq, PG8_LAS unsigned char* lds, int wid, int lane) const {
        const int row0 = u.pm * BM + wr * 64 + fr, col0 = u.pn * BM + wc * 32 + 8 * fq, bb = (u.pm * BM) >> 11;
        const float* gp = mod + (size_t)bb * E_NMOD + gidx * 1024 + col0;
        f32x4 g[2][2];
#pragma unroll
        for (int bj = 0; bj < 2; ++bj) { g[bj][0] = *(const f32x4*)(gp + bj * HALF) * scale; g[bj][1] = *(const f32x4*)(gp + bj * HALF + 4) * scale; }
        float ssq[2][4];
#define ERN_UPD(ai_, m_, bj_, b0_, b1_) do { const f32x4 o0 = (b0_) + g[bj_][0] * acc[ai_][bj_][m_][0], o1 = (b1_) + g[bj_][1] * acc[ai_][bj_][m_][1]; \
            acc[ai_][bj_][m_][0] = o0; acc[ai_][bj_][m_][1] = o1; \
            ssq[ai_][m_] += (o0[0] * o0[0] + o0[1] * o0[1]) + (o0[2] * o0[2] + o0[3] * o0[3]) + (o1[0] * o1[0] + o1[1] * o1[1]) + (o1[2] * o1[2] + o1[3] * o1[3]); \
            if (!FIN) { u32x4 w; w.x = cvt_pk_bf16(o0[0], o0[1]); w.y = cvt_pk_bf16(o0[2], o0[3]); w.z = cvt_pk_bf16(o1[0], o1[1]); w.w = cvt_pk_bf16(o1[2], o1[3]); \
                *(u32x4*)(hb + (size_t)(row0 + (ai_) * HALF + (m_) * 16) * E_HP + col0 + (bj_) * HALF) = w; } } while (0)
#pragma unroll
        for (int ai = 0; ai < 2; ++ai) {
#pragma unroll
            for (int m = 0; m < 4; ++m) ssq[ai][m] = 0.f;
            if (base_p) {
#pragma unroll
                for (int mh = 0; mh < 2; ++mh) {
                    f32x4 b[2][2][2];
#pragma unroll
                    for (int mm = 0; mm < 2; ++mm)
#pragma unroll
                        for (int bj = 0; bj < 2; ++bj) { const float* bp = base_p + (size_t)(row0 + ai * HALF + (2 * mh + mm) * 16) * 1024 + col0 + bj * HALF; b[mm][bj][0] = *(const f32x4*)bp; b[mm][bj][1] = *(const f32x4*)(bp + 4); }
#pragma unroll
                    for (int mm = 0; mm < 2; ++mm)
#pragma unroll
                        for (int bj = 0; bj < 2; ++bj) ERN_UPD(ai, 2 * mh + mm, bj, b[mm][bj][0], b[mm][bj][1]);
                    asm volatile("" ::: "memory");
                }
            } else {
                u32x4 h[4][2];
#pragma unroll
                for (int m = 0; m < 4; ++m)
#pragma unroll
                    for (int bj = 0; bj < 2; ++bj) h[m][bj] = *(const u32x4*)(hb + (size_t)(row0 + ai * HALF + m * 16) * E_HP + col0 + bj * HALF);
#pragma unroll
                for (int m = 0; m < 4; ++m)
#pragma unroll
                    for (int bj = 0; bj < 2; ++bj) { const u32x4 x = h[m][bj]; const f32x4 b0 = {bflo(x.x), bfhi(x.x), bflo(x.y), bfhi(x.y)}, b1 = {bflo(x.z), bfhi(x.z), bflo(x.w), bfhi(x.w)}; ERN_UPD(ai, m, bj, b0, b1); }
                asm volatile("" ::: "memory");
            }
        }
#undef ERN_UPD
        PG8_LAS float* red = (PG8_LAS float*)lds;
#pragma unroll
        for (int ai = 0; ai < 2; ++ai)
#pragma unroll
            for (int m = 0; m < 4; ++m) { const float t = rows_sum4(ssq[ai][m]); if (fq == 0) red[wc * 256 + wr * 64 + ai * HALF + m * 16 + fr] = t; }
        asm volatile("s_waitcnt lgkmcnt(0)" ::: "memory"); __builtin_amdgcn_s_barrier(); asm volatile("" ::: "memory");
        const int tid = wid * 64 + lane;
        if (tid < 256) { const float t = (red[tid] + red[256 + tid]) + (red[512 + tid] + red[768 + tid]); float* p = rowss + (size_t)(u.pm * BM + tid) * 4 + u.pn;
            asm volatile("global_store_dword %0, %1, off sc1" :: "v"(p), "v"(t) : "memory"); }
        asm volatile("s_waitcnt vmcnt(0) lgkmcnt(0)" ::: "memory"); __builtin_amdgcn_s_barrier(); asm volatile("" ::: "memory");
        if (tid == 0) { unsigned* f = flag + u.pm * 16; (void)__hip_atomic_fetch_add(f, 1u, __ATOMIC_RELAXED, __HIP_MEMORY_SCOPE_AGENT);
            unsigned sp = 0u; while (__hip_atomic_load(f, __ATOMIC_RELAXED, __HIP_MEMORY_SCOPE_AGENT) < 4u) { __builtin_amdgcn_s_sleep(1); if (++sp > (1u << 18)) break; } }
        asm volatile("s_waitcnt vmcnt(0) lgkmcnt(0)" ::: "memory"); __builtin_amdgcn_s_barrier(); asm volatile("" ::: "memory");
        float rstd[2][4];
        { f32x4 ps[2][4]; const float* p0 = rowss + (size_t)row0 * 4;
#pragma unroll
          for (int ai = 0; ai < 2; ++ai)
#pragma unroll
              for (int m = 0; m < 4; ++m) { const float* p = p0 + (size_t)(ai * HALF + m * 16) * 4; asm volatile("global_load_dwordx4 %0, %1, off sc1" : "=v"(ps[ai][m]) : "v"(p) : "memory"); }
          asm volatile("s_waitcnt vmcnt(0)" : "+v"(ps[0][0]), "+v"(ps[0][1]), "+v"(ps[0][2]), "+v"(ps[0][3]), "+v"(ps[1][0]), "+v"(ps[1][1]), "+v"(ps[1][2]), "+v"(ps[1][3]) :: "memory");
#pragma unroll
          for (int ai = 0; ai < 2; ++ai)
#pragma unroll
              for (int m = 0; m < 4; ++m) { const f32x4 t = ps[ai][m]; rstd[ai][m] = __builtin_amdgcn_rsqf(((t.x + t.y) + (t.z + t.w)) * (1.0f / 1024.0f) + E_NORM_EPS); } }
#pragma unroll
        for (int bj = 0; bj < 2; ++bj) {
            f32x4 A_[2], B_[2];
#pragma unroll
            for (int e = 0; e < 2; ++e) { const int c = col0 + bj * HALF + 4 * e; A_[e] = *(const f32x4*)(gn + c); B_[e] = (f32x4){0.f, 0.f, 0.f, 0.f};
                if (!FIN) { A_[e] = A_[e] * (*(const f32x4*)(mod + (size_t)bb * E_NMOD + sc_idx * 1024 + c) + 1.0f); B_[e] = *(const f32x4*)(mod + (size_t)bb * E_NMOD + sh_idx * 1024 + c); } }
#pragma unroll
            for (int ai = 0; ai < 2; ++ai)
#pragma unroll
                for (int m = 0; m < 4; ++m) { const size_t row = (size_t)(row0 + ai * HALF + m * 16); const int c = col0 + bj * HALF;
                    const f32x4 x0 = (acc[ai][bj][m][0] * rstd[ai][m]) * A_[0] + B_[0], x1 = (acc[ai][bj][m][1] * rstd[ai][m]) * A_[1] + B_[1];
                    if (FIN) { *(f32x4*)(y + row * 1024 + c) = x0; *(f32x4*)(y + row * 1024 + c + 4) = x1; }
                    else if (xn8) { *(u32x2*)((unsigned char*)xn + row * 1024 + c) = (u32x2){cvt4_fp8(x0[0] * F8_SX, x0[1] * F8_SX, x0[2] * F8_SX, x0[3] * F8_SX), cvt4_fp8(x1[0] * F8_SX, x1[1] * F8_SX, x1[2] * F8_SX, x1[3] * F8_SX)}; }
                    else { u32x4 w; w.x = cvt_pk_bf16(x0[0], x0[1]); w.y = cvt_pk_bf16(x0[2], x0[3]); w.z = cvt_pk_bf16(x1[0], x1[1]); w.w = cvt_pk_bf16(x1[2], x1[3]);
                        *(u32x4*)(xn + row * 1024 + c) = w;
                        if (xc) *(u32x2*)(xc + row * 4096 + c) = (u32x2){cvt4_fp8(x0[0] * F8_SX, x0[1] * F8_SX, x0[2] * F8_SX, x0[3] * F8_SX), cvt4_fp8(x1[0] * F8_SX, x1[1] * F8_SX, x1[2] * F8_SX, x1[3] * F8_SX)}; } }
        }
    }
};
typedef EpiResNormT<false> EpiResNorm; typedef EpiResNormT<true> EpiResNormFin;

struct EpiSlab {
    static constexpr bool PERM = true, AFTER_DRAIN = false;
    float* slab; const float* mod; int gidx; float scale; int ks;
    __device__ __forceinline__ void operator()(const f32x4 (&acc)[2][2][4][2], const Unit& u, int wr, int wc, int fr, int fq) const {
        const int row0 = u.pm * BM + wr * 64 + fr, col0 = u.pn * BM + wc * 32 + 8 * fq;
        float* sl = slab + (size_t)(u.ko / ks) * (E_M - E_MP) * 1024;
#pragma unroll
        for (int ai = 0; ai < 2; ++ai) {
            if (row0 + ai * HALF + 48 < E_M) {
                f32x4 g[4][2][2];
#pragma unroll
                for (int m = 0; m < 4; ++m) { const float* gp = mod + (size_t)row_batch(row0 + ai * HALF + m * 16) * E_NMOD + gidx * 1024 + col0;
#pragma unroll
                    for (int bj = 0; bj < 2; ++bj) { g[m][bj][0] = *(const f32x4*)(gp + bj * HALF); g[m][bj][1] = *(const f32x4*)(gp + bj * HALF + 4); } }
#pragma unroll
                for (int m = 0; m < 4; ++m) { float* op = sl + (size_t)(row0 + ai * HALF + m * 16 - E_MP) * 1024 + col0;
#pragma unroll
                    for (int bj = 0; bj < 2; ++bj)
#pragma unroll
                        for (int n = 0; n < 2; ++n) *(f32x4*)(op + bj * HALF + n * 4) = (g[m][bj][n] * scale) * acc[ai][bj][m][n]; }
            }
        }
    }
};
struct EpiResSlab {
    static constexpr bool PERM = true, AFTER_DRAIN = false;
    EpiRes a; EpiSlab s;
    __device__ __forceinline__ void operator()(const f32x4 (&acc)[2][2][4][2], const Unit& u, int wr, int wc, int fr, int fq) const { if (u.nt) s(acc, u, wr, wc, fr, fq); else a(acc, u, wr, wc, fr, fq); }
};
struct EpiChain {
    static constexpr bool PERM = true, AFTER_DRAIN = false;
    EpiWin w; EpiYr y; EpiGlu g;
    __device__ __forceinline__ void operator()(const f32x4 (&acc)[2][2][4][2], const Unit& u, int wr, int wc, int fr, int fq) const {
        if (u.kind == 0) w(acc, u, wr, wc, fr, fq); else if (u.kind == 1) y(acc, u, wr, wc, fr, fq); else g(acc, u, wr, wc, fr, fq);
    }
};
template <class Epi, class Sched, bool ALIGN_EPI = false, bool SP2 = false, bool F8 = false>
__device__ __forceinline__ void gemm_phase(PG8_LAS unsigned char* lds, const Gemm g, const Sched& S, const Epi& E) {
    const int tid = threadIdx.x, wid = __builtin_amdgcn_readfirstlane(tid >> 6), lane = tid & 63, wr = wid >> 2, wc = wid & 3, fr = lane & 15, fq = lane >> 4;
    const int K = g.ld, nt = g.K / BK;
    int vR[2], vRb[2], vC[2];
#pragma unroll
    for (int i = 0; i < 2; ++i) { int R, C; stage_rc(tid * 16 + i * 8192, R, C); vR[i] = R; vRb[i] = Epi::PERM ? ((R & ~31) + perm32(R & 31)) : R; vC[i] = C; }
#define PG8_LDOF(u_) (((u_).kind == 1 && g.ld1) ? g.ld1 : K)
#define PG8_SETLD(ld_, vA_, vB_, hs_) do { _Pragma("unroll") for (int _i = 0; _i < 2; ++_i) { vA_[_i] = (unsigned)(vR[_i] * (ld_) + vC[_i]) * 2u; vB_[_i] = (unsigned)(vRb[_i] * (ld_) + vC[_i]) * 2u; } hs_ = (size_t)HALF * (ld_) * 2; } while (0)
    unsigned voffA[2], voffB[2], voffAn[2], voffBn[2];
    size_t hstep, hstepn;
    const size_t kstep = (size_t)(BK * 2);
    const unsigned ldsw = (unsigned)wid * 1024u;
    const int aoff = lds_byte(wr * 64 + fr, fq * 8), boff = lds_byte(wc * 32 + fr, fq * 8);
#define PG8_SA(b, h) (((b) * 2 + (h)) * HTB)
#define PG8_SB(b, h) ((4 + (b) * 2 + (h)) * HTB)
#define PG8_STAGE(bufoff, gbase, voff) do { _Pragma("unroll") for (int _i = 0; _i < 2; ++_i) \
        __builtin_amdgcn_global_load_lds((const unsigned*)((const char*)(gbase) + (voff)[_i]), (PG8_LAS unsigned*)(lds + (bufoff) + ldsw + _i * 8192), 16, 0, 0); } while (0)
#define PG8_LDA(dst, b, h) do { _Pragma("unroll") for (int m = 0; m < 4; ++m) _Pragma("unroll") for (int k = 0; k < 2; ++k) dst[m][k] = *(const PG8_LAS bf16x8*)(lds + PG8_SA(b, h) + aoff + m * 2048 + k * 1024); } while (0)
#define PG8_LDB(dst, b, h) do { _Pragma("unroll") for (int n = 0; n < 2; ++n) _Pragma("unroll") for (int k = 0; k < 2; ++k) dst[n][k] = *(const PG8_LAS bf16x8*)(lds + PG8_SB(b, h) + boff + n * 2048 + k * 1024); } while (0)
#define PG8_F8CAT(x0_, x1_) __builtin_shufflevector(__builtin_bit_cast(v4i32, x0_), __builtin_bit_cast(v4i32, x1_), 0, 1, 2, 3, 4, 5, 6, 7)
#define PG8_MMA(ai, bj, At, Bt) do { \
        if constexpr (F8) { v8i32 a8_[4], b8_[2]; \
            _Pragma("unroll") for (int m = 0; m < 4; ++m) a8_[m] = PG8_F8CAT(At[m][0], At[m][1]); \
            _Pragma("unroll") for (int n = 0; n < 2; ++n) b8_[n] = PG8_F8CAT(Bt[n][0], Bt[n][1]); \
            __builtin_amdgcn_s_setprio(1); \
            _Pragma("unroll") for (int m = 0; m < 4; ++m) _Pragma("unroll") for (int n = 0; n < 2; ++n) \
                asm volatile("v_mfma_scale_f32_16x16x128_f8f6f4 %0, %1, %2, %0, %3, %3 op_sel_hi:[0,0,0]" : "+v"(acc[ai][bj][m][n]) : "v"(b8_[n]), "v"(a8_[m]), "v"(f8one));   \
            __builtin_amdgcn_s_setprio(0); \
            } \
        else { __builtin_amdgcn_s_setprio(1); \
            _Pragma("unroll") for (int m = 0; m < 4; ++m) _Pragma("unroll") for (int n = 0; n < 2; ++n) _Pragma("unroll") for (int k = 0; k < 2; ++k) \
                acc[ai][bj][m][n] = __builtin_amdgcn_mfma_f32_16x16x32_bf16(Bt[n][k], At[m][k], acc[ai][bj][m][n], 0, 0, 0); \
            __builtin_amdgcn_s_setprio(0); \
              \
            asm volatile("" :: "v"(At[0][0]), "v"(At[0][1]), "v"(At[1][0]), "v"(At[1][1]), "v"(At[2][0]), "v"(At[2][1]), "v"(At[3][0]), "v"(At[3][1]), "v"(Bt[0][0]), "v"(Bt[0][1]), "v"(Bt[1][0]), "v"(Bt[1][1])); } } while (0)
#define PG8_WAIT_V(n) asm volatile("s_waitcnt vmcnt(" #n ")" ::: "memory")
#define PG8_WAIT_L(n) asm volatile("s_waitcnt lgkmcnt(" #n ")" ::: "memory")
#define PG8_BAR __builtin_amdgcn_s_barrier()
#define PG8_SCHED __builtin_amdgcn_sched_barrier(0)
    Unit cur, nxt; int ui = 0;
    if (!S.next(0, cur)) return;
    f32x4 acc[2][2][4][2];
#pragma unroll
    for (int a = 0; a < 2; ++a)
#pragma unroll
        for (int b = 0; b < 2; ++b)
#pragma unroll
            for (int m = 0; m < 4; ++m)
#pragma unroll
                for (int n = 0; n < 2; ++n) { acc[a][b][m][n] = (f32x4){0.f, 0.f, 0.f, 0.f}; asm volatile("" : "+v"(acc[a][b][m][n])); }
    bf16x8 At[4][2], B0[2][2], B1[2][2];
    int f8one = 0x7f7f7f7f; asm volatile("" : "+v"(f8one));
    PG8_SETLD(PG8_LDOF(cur), voffA, voffB, hstep);
    const char* cA = (const char*)(cur.kind == 0 ? g.A[0] : cur.kind == 1 ? g.A[1] : g.A[2]) + (size_t)cur.pm * (2 * hstep) + (size_t)cur.ko * 2; const char* cB = (const char*)(cur.kind == 0 ? g.Bt[0] : cur.kind == 1 ? g.Bt[1] : g.Bt[2]) + (size_t)cur.pn * (2 * hstep) + (size_t)cur.ko * 2;
    S.a_ready(cur);
    if constexpr (SP2) {
        PG8_STAGE(PG8_SB(0, 0), cB, voffB); PG8_STAGE(PG8_SB(0, 1), cB + hstep, voffB); PG8_STAGE(PG8_SA(0, 0), cA, voffA); PG8_STAGE(PG8_SA(0, 1), cA + hstep, voffA);
        if (wr == 1) PG8_BAR;
        PG8_WAIT_V(2); PG8_BAR;
        PG8_STAGE(PG8_SB(1, 0), cB + kstep, voffB); PG8_STAGE(PG8_SA(1, 0), cA + kstep, voffA); PG8_STAGE(PG8_SB(1, 1), cB + hstep + kstep, voffB);
        PG8_WAIT_V(6); PG8_BAR;
    } else {
        PG8_STAGE(PG8_SB(0, 0), cB, voffB); PG8_STAGE(PG8_SA(0, 0), cA, voffA); PG8_STAGE(PG8_SB(0, 1), cB + hstep, voffB); PG8_STAGE(PG8_SA(0, 1), cA + hstep, voffA);
        if (wr == 1) PG8_BAR;
        PG8_WAIT_V(4); PG8_BAR;
        PG8_STAGE(PG8_SB(1, 0), cB + kstep, voffB); PG8_STAGE(PG8_SA(1, 0), cA + kstep, voffA); PG8_STAGE(PG8_SB(1, 1), cB + hstep + kstep, voffB);
        PG8_WAIT_V(6); PG8_BAR;
    }
    for (;;) {
        const bool has_next = S.next(ui + 1, nxt);
        if (has_next && !F8) PG8_SETLD(PG8_LDOF(nxt), voffAn, voffBn, hstepn); else { voffAn[0] = voffA[0]; voffAn[1] = voffA[1]; voffBn[0] = voffB[0]; voffBn[1] = voffB[1]; hstepn = hstep; }
        const char* nA = has_next ? (const char*)(nxt.kind == 0 ? g.A[0] : nxt.kind == 1 ? g.A[1] : g.A[2]) + (size_t)nxt.pm * (2 * hstepn) + (size_t)nxt.ko * 2 : cA; const char* nB = has_next ? (const char*)(nxt.kind == 0 ? g.Bt[0] : nxt.kind == 1 ? g.Bt[1] : g.Bt[2]) + (size_t)nxt.pn * (2 * hstepn) + (size_t)nxt.ko * 2 : cB;
        const int unt = cur.nt ? cur.nt : nt;
        for (int t = 0; t < unt; t += 2) {
            const bool last = (t == unt - 2);
            const char* a1 = cA + (size_t)(t + 1) * kstep;
            const char* a2 = last ? nA : cA + (size_t)(t + 2) * kstep; const char* b2 = last ? nB : cB + (size_t)(t + 2) * kstep;
            const char* a3 = a2 + kstep; const char* b3 = b2 + kstep;
            unsigned vA2[2], vB2[2]; vA2[0] = last ? voffAn[0] : voffA[0]; vA2[1] = last ? voffAn[1] : voffA[1]; vB2[0] = last ? voffBn[0] : voffB[0]; vB2[1] = last ? voffBn[1] : voffB[1];
            const size_t hstep2 = last ? hstepn : hstep;
            if (last && has_next) S.a_ready(nxt);
            if constexpr (SP2) {
            PG8_LDB(B0, 0, 0); PG8_LDB(B1, 0, 1); PG8_SCHED; PG8_LDA(At, 0, 0); PG8_STAGE(PG8_SA(1, 1), a1 + hstep, voffA);
            PG8_WAIT_V(8); PG8_WAIT_L(0); PG8_BAR; PG8_MMA(0, 0, At, B0); PG8_MMA(0, 1, At, B1); PG8_BAR; PG8_SCHED;
            PG8_LDA(At, 0, 1); PG8_STAGE(PG8_SB(0, 0), b2, vB2); PG8_STAGE(PG8_SB(0, 1), b2 + hstep2, vB2); PG8_STAGE(PG8_SA(0, 0), a2, vA2);
            PG8_WAIT_V(8); PG8_WAIT_L(0); PG8_BAR; PG8_MMA(1, 0, At, B0); PG8_MMA(1, 1, At, B1); PG8_BAR; PG8_SCHED;
            PG8_LDB(B0, 1, 0); PG8_LDB(B1, 1, 1); PG8_SCHED; PG8_LDA(At, 1, 0); PG8_STAGE(PG8_SA(0, 1), a2 + hstep2, vA2);
            PG8_WAIT_V(8); PG8_WAIT_L(0); PG8_BAR; PG8_MMA(0, 0, At, B0); PG8_MMA(0, 1, At, B1); PG8_BAR; PG8_SCHED;
            PG8_LDA(At, 1, 1); PG8_STAGE(PG8_SB(1, 0), b3, vB2); PG8_STAGE(PG8_SB(1, 1), b3 + hstep2, vB2); PG8_STAGE(PG8_SA(1, 0), a3, vA2);
            PG8_WAIT_V(8); PG8_WAIT_L(0); PG8_BAR; PG8_MMA(1, 0, At, B0); PG8_MMA(1, 1, At, B1); PG8_BAR; PG8_SCHED;
            } else {
            PG8_LDB(B0, 0, 0); PG8_SCHED; PG8_LDA(At, 0, 0); PG8_STAGE(PG8_SA(1, 1), a1 + hstep, voffA);
            PG8_WAIT_L(8); PG8_BAR; PG8_WAIT_L(0); PG8_MMA(0, 0, At, B0); PG8_BAR; PG8_SCHED;
            PG8_LDB(B1, 0, 1); PG8_STAGE(PG8_SB(0, 0), b2, vB2);
            PG8_BAR; PG8_WAIT_L(0); PG8_MMA(0, 1, At, B1); PG8_BAR;
            PG8_LDA(At, 0, 1); PG8_STAGE(PG8_SA(0, 0), a2, vA2);
            PG8_BAR; PG8_WAIT_L(0); PG8_MMA(1, 0, At, B0); PG8_BAR; PG8_SCHED;
            PG8_STAGE(PG8_SB(0, 1), b2 + hstep2, vB2);
            PG8_WAIT_V(6); PG8_BAR; PG8_MMA(1, 1, At, B1); PG8_BAR;
            PG8_LDB(B0, 1, 0); PG8_SCHED; PG8_LDA(At, 1, 0); PG8_STAGE(PG8_SA(0, 1), a2 + hstep2, vA2);
            PG8_WAIT_L(8); PG8_BAR; PG8_WAIT_L(0); PG8_MMA(0, 0, At, B0); PG8_BAR; PG8_SCHED;
            PG8_LDB(B1, 1, 1); PG8_STAGE(PG8_SB(1, 0), b3, vB2);
            PG8_BAR; PG8_WAIT_L(0); PG8_MMA(0, 1, At, B1); PG8_BAR;
            PG8_LDA(At, 1, 1); PG8_STAGE(PG8_SA(1, 0), a3, vA2);
            PG8_BAR; PG8_WAIT_L(0); PG8_MMA(1, 0, At, B0); PG8_BAR; PG8_SCHED;
            PG8_STAGE(PG8_SB(1, 1), b3 + hstep2, vB2);
            PG8_WAIT_V(6); PG8_BAR; PG8_MMA(1, 1, At, B1); PG8_BAR;
            }
        }
        if constexpr (ALIGN_EPI) { if (wr == 0) PG8_BAR; }
        if constexpr (F8) asm volatile("s_nop 15\n\ts_nop 15" ::: "memory");
        if constexpr (!Epi::AFTER_DRAIN) { E(acc, cur, wr, wc, fr, fq); S.done(cur); }
        if (!has_next) break;
#pragma unroll
        for (int a = 0; a < 2; ++a)
#pragma unroll
            for (int b = 0; b < 2; ++b)
#pragma unroll
                for (int m = 0; m < 4; ++m)
#pragma unroll
                    for (int n = 0; n < 2; ++n) { acc[a][b][m][n] = (f32x4){0.f, 0.f, 0.f, 0.f}; asm volatile("" : "+v"(acc[a][b][m][n])); }
        cur = nxt; cA = nA; cB = nB; ++ui; voffA[0] = voffAn[0]; voffA[1] = voffAn[1]; voffB[0] = voffBn[0]; voffB[1] = voffBn[1]; hstep = hstepn;
        if constexpr (ALIGN_EPI) { if (wr == 1) PG8_BAR; }
    }
    PG8_WAIT_V(0);
    if constexpr (!ALIGN_EPI) { if (wr == 0) PG8_BAR; }
    PG8_BAR;
    if constexpr (F8) asm volatile("s_nop 15\n\ts_nop 15" ::: "memory");
    if constexpr (Epi::AFTER_DRAIN) { E.fused(acc, cur, wr, wc, fr, fq, lds, wid, lane); S.done(cur); }
#undef PG8_SA
#undef PG8_SB
#undef PG8_STAGE
#undef PG8_LDA
#undef PG8_LDB
#undef PG8_MMA
#undef PG8_WAIT_V
#undef PG8_WAIT_L
#undef PG8_BAR
#undef PG8_SCHED
}
}

constexpr int NWAVES = 8;
constexpr int D = 1024, MP = 16384, MS = 128, M = 16512, MPAD = 16640, SEQ = 2048, NB = 136, NMOD = 9216;
constexpr int DFF = 2816, NIN = 4352, NSHIFT = 1792, S5W = 512, RWW = 512;
constexpr float NORM_EPS = 1e-6f, GN_EPS = 64e-5f;
enum { I_XP = 0, I_XS, I_CP, I_CS, I_S5RE, I_S5IM, I_WKV, I_SHIFT, I_WADA, I_BADA, I_GFFN1, I_GMIX, I_GFFN2, I_GFINAL,
       I_F1W1, I_F1W3, I_F1W2, I_F2W1, I_F2W3, I_F2W2, I_WIN, I_MU, I_LAMRE, I_LAMIM, I_LOGDT, I_BRE, I_BIM, I_CRE, I_CIM, I_S5D, I_GLUV, I_GLUG,
       I_W0, I_W2, I_A0, I_A2, I_G2, I_KK, I_KA, I_RK, I_LNW, I_LNB, I_PROJ, I_WOUT, N_IN_T };
constexpr size_t O_Y = 0, O_S5RE_P = 16908288, O_S5IM_P = 16924672, O_WKV_P = 16941056, O_SHIFT_P = 17203200,
                 O_S5RE_S = 17217536, O_S5IM_S = 17479680, O_WKV_S = 17741824, O_SHIFT_S = 21936128, O_TOTAL = 22165504;
constexpr size_t MiB = 1u << 20;
constexpr size_t WS_CTL = 0, CTL_ZERO_BYTES = 64 * 1024;
constexpr size_t WS_WADA = 1 * MiB;
constexpr size_t WS_OZ = 1 * MiB;
constexpr size_t WS_Z = WS_OZ;
constexpr int OZP = 1024;
constexpr size_t WS_W13_1 = 19 * MiB;
constexpr size_t WS_W2_1 = 30 * MiB;
constexpr size_t WS_O = WS_OZ + 512 * 2;
constexpr size_t WS_W13_2 = 36 * MiB, WS_W2_2 = 41 * MiB + 512 * 1024, WS_WIN8 = 44 * MiB + 512 * 1024;
constexpr size_t WS_WIN = 53 * MiB;
constexpr size_t WS_GLU = 62 * MiB;
constexpr size_t WS_PROJ = 64 * MiB;
constexpr size_t WS_WOUT = 65 * MiB;
constexpr size_t WS_SC = 67 * MiB;
constexpr size_t WS_LORA = 67 * MiB + 512 * 1024;
constexpr size_t WS_S5PAR = 67 * MiB + 768 * 1024;
constexpr size_t WS_MOD = 68 * MiB;
constexpr size_t WS_SLAB = 246 * MiB;
constexpr size_t WS_GPT = 251 * MiB + 512 * 1024;
constexpr size_t WS_XN = 73 * MiB;
constexpr size_t WS_BIG = 106 * MiB;
constexpr size_t WS_S5IN = WS_BIG, WS_CUR = WS_S5IN + (size_t)MPAD * 512 * 2, WS_GATES = WS_CUR + (size_t)MPAD * 1792 * 2, WS_END = WS_GATES + (size_t)MPAD * 2048 * 2;
static_assert(WS_END <= 256 * MiB, "d_ws map");
static_assert(WS_OZ + (size_t)MPAD * OZP * 2 <= WS_W13_2, "Z | O overlay");

constexpr int RING_BYTES = 131072;
constexpr int MISC_OFF = 159744 - 256;
constexpr int LDS_BYTES = 159744;

#define GAS __attribute__((address_space(1)))
#define LAS __attribute__((address_space(3)))
typedef unsigned short bf16;
typedef unsigned v4u __attribute__((ext_vector_type(4)));
typedef unsigned v2u __attribute__((ext_vector_type(2)));
typedef float f32x4 __attribute__((ext_vector_type(4)));
#define LDS_WAIT() asm volatile("s_waitcnt lgkmcnt(0)" ::: "memory")
#define VM_WAIT() asm volatile("s_waitcnt vmcnt(0)" ::: "memory")
__device__ __forceinline__ unsigned f2bf(float f) { unsigned u = __builtin_bit_cast(unsigned, f); return (u + 0x7fffu + ((u >> 16) & 1u)) >> 16; }
__device__ __forceinline__ unsigned pk2(float lo, float hi) { return pg8::cvt_pk_bf16(lo, hi); }
__device__ __forceinline__ unsigned pk4f8(float a, float b, float c, float d) { return pg8::cvt4_fp8(a, b, c, d); }
__device__ __forceinline__ unsigned cvtpk(float lo, float hi) { return pg8::cvt_pk_bf16(lo, hi); }
__device__ __forceinline__ float bf2f(unsigned short h) { return __uint_as_float((unsigned)h << 16); }
__device__ __forceinline__ float bflo(unsigned w) { return __uint_as_float(w << 16); }
__device__ __forceinline__ float bfhi(unsigned w) { return __uint_as_float(w & 0xffff0000u); }
__device__ __forceinline__ float wave_sum(float v) {
#pragma unroll
    for (int o = 1; o < 64; o <<= 1) v += __shfl_xor(v, o);
    return v;
}
__device__ __forceinline__ float sigmoidf_(float x) { return __builtin_amdgcn_rcpf(1.0f + __expf(-x)); }
__device__ __forceinline__ float tanhf_(float x) { const float e = __expf(2.0f * x); return 1.0f - 2.0f * __builtin_amdgcn_rcpf(e + 1.0f); }
__device__ __forceinline__ float gelu_tanh(float y) { const float a2 = 1.5957691216057308f * (y + 0.044715f * y * y * y); return y * __builtin_amdgcn_rcpf(1.0f + __expf(-a2)); }
__device__ __forceinline__ float softplusf_(float x) { return fmaxf(x, 0.f) + log1pf(__expf(-fabsf(x))); }

struct Args { const float* in[N_IN_T]; float* out; unsigned char* ws; int ph_lo, ph_hi; };
static_assert(sizeof(Args) == N_IN_T * 8 + 8 + 8 + 8, "Args has no padding");
struct Frame {
    LAS unsigned char* lds;
    int tid, lane, wave, G, bid;
    const Args* a;
};

struct TItem { const float* W; bf16* WT; int N, il, ldw, item; float f8; };
__device__ __forceinline__ void p0_item_load(const TItem& t, f32x4 (&v)[8], int lane) {
    const int nblk = t.N / 32, kb = t.item / nblk, nb = t.item % nblk;
    const float* p = t.W + (size_t)(64 * kb + (lane >> 3)) * t.N + 32 * nb + 4 * (lane & 7);
#pragma unroll
    for (int i = 0; i < 8; ++i) v[i] = *(const GAS f32x4*)(p + (size_t)(8 * i) * t.N);
}
__device__ __forceinline__ void p0_item_store(const TItem& t, const f32x4 (&v)[8], LAS float* scr, int lane, unsigned char* w8, const bf16* wout_wt) {
    const int nblk = t.N / 32, kb = t.item / nblk, nb = t.item % nblk, k0 = 64 * kb, n0 = 32 * nb;
    const int r0 = t.il == 0 ? n0 : (256 * (n0 >> 7) + (t.il == 2 ? 128 : 0) + (n0 & 127));
#pragma unroll
    for (int i = 0; i < 8; ++i) { LAS float* s = scr + (8 * i + (lane >> 3)) * 33 + 4 * (lane & 7); s[0] = v[i].x; s[1] = v[i].y; s[2] = v[i].z; s[3] = v[i].w; }
    LDS_WAIT(); asm volatile("" ::: "memory");
    const int c = lane & 7;
#pragma unroll
    for (int j = 0; j < 4; ++j) { const int n = (lane >> 3) + 8 * j; const LAS float* s = scr + (8 * c) * 33 + n;
        if (t.f8 != 0.f) { const float q = t.f8;
            *(GAS v2u*)((unsigned char*)t.WT + (size_t)(r0 + n) * t.ldw + k0 + 8 * c) = (v2u){pk4f8(q * s[0 * 33], q * s[1 * 33], q * s[2 * 33], q * s[3 * 33]), pk4f8(q * s[4 * 33], q * s[5 * 33], q * s[6 * 33], q * s[7 * 33])}; }
        else { v4u o; o.x = pk2(s[0 * 33], s[1 * 33]); o.y = pk2(s[2 * 33], s[3 * 33]); o.z = pk2(s[4 * 33], s[5 * 33]); o.w = pk2(s[6 * 33], s[7 * 33]);
            *(GAS v4u*)(t.WT + (size_t)(r0 + n) * t.ldw + k0 + 8 * c) = o;
            if (t.WT == wout_wt) { const float q = pg8::F8_SW13;
                *(GAS v2u*)(w8 + (size_t)(r0 + n) * 4096 + 1024 + k0 + 8 * c) = (v2u){pk4f8(q * s[0 * 33], q * s[1 * 33], q * s[2 * 33], q * s[3 * 33]), pk4f8(q * s[4 * 33], q * s[5 * 33], q * s[6 * 33], q * s[7 * 33])}; }
            if (t.N == NIN && r0 + n >= 2304) { const float q = pg8::F8_SW13;
                *(GAS v2u*)(w8 + (size_t)(r0 + n - 2304) * 4096 + k0 + 8 * c) = (v2u){pk4f8(q * s[0 * 33], q * s[1 * 33], q * s[2 * 33], q * s[3 * 33]), pk4f8(q * s[4 * 33], q * s[5 * 33], q * s[6 * 33], q * s[7 * 33])}; } } }
    LDS_WAIT(); asm volatile("" ::: "memory");
}
constexpr int P0_I_ADA = (D / 64) * (NMOD / 32), P0_I_UP = (D / 64) * (DFF / 32), P0_I_DN = (DFF / 64) * (D / 32), P0_I_IN = (D / 64) * (NIN / 32), P0_I_GL = (512 / 64) * (D / 32), P0_I_OUT = (D / 64) * (D / 32);
constexpr int P0_NLATE = 2 * P0_I_UP + P0_I_DN;
constexpr int P0_NREST = 2 * P0_I_UP + P0_I_DN + P0_I_IN + 3 * P0_I_GL + P0_I_OUT + 16 + 16 + 32;
__device__ __forceinline__ TItem p0_item(const Frame& F, int part, int it) {
    unsigned char* ws = F.a->ws;
    if (part == 0) return TItem{F.a->in[I_WADA], (bf16*)(ws + WS_WADA), NMOD, 0, D, it, 0.f};
    int r = it;
    if (part == 1) { if (r >= 2 * P0_I_UP + P0_I_DN) r += P0_NLATE; }
    else r += 2 * P0_I_UP + P0_I_DN;
    if (r < P0_I_UP) return TItem{F.a->in[I_F1W1], (bf16*)(ws + WS_W13_1), DFF, 1, D, r, pg8::F8_SW13}; r -= P0_I_UP;
    if (r < P0_I_UP) return TItem{F.a->in[I_F1W3], (bf16*)(ws + WS_W13_1), DFF, 2, D, r, pg8::F8_SW13}; r -= P0_I_UP;
    if (r < P0_I_DN) return TItem{F.a->in[I_F1W2], (bf16*)(ws + WS_W2_1), D, 0, DFF, r, pg8::F8_SW2}; r -= P0_I_DN;
    if (r < P0_I_UP) return TItem{F.a->in[I_F2W1], (bf16*)(ws + WS_W13_2), DFF, 1, D, r, pg8::F8_SW13}; r -= P0_I_UP;
    if (r < P0_I_UP) return TItem{F.a->in[I_F2W3], (bf16*)(ws + WS_W13_2), DFF, 2, D, r, pg8::F8_SW13}; r -= P0_I_UP;
    if (r < P0_I_DN) return TItem{F.a->in[I_F2W2], (bf16*)(ws + WS_W2_2), D, 0, DFF, r, pg8::F8_SW2}; r -= P0_I_DN;
    if (r < P0_I_IN) return TItem{F.a->in[I_WIN], (bf16*)(ws + WS_WIN), NIN, 0, D, r, 0.f}; r -= P0_I_IN;
    if (r < P0_I_GL) return TItem{F.a->in[I_GLUV], (bf16*)(ws + WS_GPT), D, 1, 1024, r, 0.f}; r -= P0_I_GL;
    if (r < P0_I_GL) return TItem{F.a->in[I_GLUG], (bf16*)(ws + WS_GPT), D, 2, 1024, r, 0.f}; r -= P0_I_GL;
    if (r < P0_I_GL) return TItem{F.a->in[I_PROJ], (bf16*)(ws + WS_GPT) + 512, D, 0, 1024, r, 0.f}; r -= P0_I_GL;
    if (r < P0_I_OUT) return TItem{F.a->in[I_WOUT], (bf16*)(ws + WS_WOUT), D, 0, D, r, 0.f}; r -= P0_I_OUT;
    if (r < 16) return TItem{F.a->in[I_W2], (bf16*)(ws + WS_LORA), 512, 0, 64, r, 0.f}; r -= 16;
    if (r < 16) return TItem{F.a->in[I_A2], (bf16*)(ws + WS_LORA) + 512 * 64, 512, 0, 64, r, 0.f}; r -= 16;
    return TItem{F.a->in[I_G2], (bf16*)(ws + WS_LORA) + 2 * 512 * 64, 512, 0, 128, r, 0.f};
}
__device__ __forceinline__ void p0_prologue(Frame& F, int part, int wg0) {
    LAS float* scr = (LAS float*)(F.lds + F.wave * 16384);
    if (F.bid >= wg0) {
        const int gw = (F.bid - wg0) * NWAVES + F.wave, NGW = (F.G - wg0) * NWAVES, nit = part == 0 ? P0_I_ADA : part == 1 ? P0_NREST : P0_NLATE;
        if (gw < nit) {
            TItem tn = p0_item(F, part, gw); f32x4 vn[8];
            p0_item_load(tn, vn, F.lane);
            for (int it = gw; it < nit; it += NGW) {
                const TItem t = tn; f32x4 v[8];
#pragma unroll
                for (int i = 0; i < 8; ++i) v[i] = vn[i];
                if (it + NGW < nit) { tn = p0_item(F, part, it + NGW); p0_item_load(tn, vn, F.lane); }
                p0_item_store(t, v, scr, F.lane, F.a->ws + WS_WIN8, (const bf16*)(F.a->ws + WS_WOUT));
            }
        }
    }
    if (part == 0) {
        bf16* sc = (bf16*)(F.a->ws + WS_SC);
        for (int i = F.bid * 512 + F.tid; i < 256 * D; i += F.G * 512) {
            const int b = i >> 10, k = i & 1023; float v = 0.f;
            if (b < NB) { const float c = b < 8 ? F.a->in[I_CP][b * D + k] : F.a->in[I_CS][(b - 8) * D + k]; v = c * sigmoidf_(c); }
            sc[i] = (bf16)f2bf(v);
        }
    }
}

constexpr int HP = 2048;
template <bool FINAL, bool SRCF32>
__device__ __forceinline__ void norm_phase(Frame& F, const float* src_p, const float* src_s, bf16* hb, const float* g, int sh_idx, int sc_idx, bf16* xn, float* y, const float* slab, int nslab) {
    const int gw = F.bid * NWAVES + F.wave, NGW = F.G * NWAVES;
    const float* mod = (const float*)(F.a->ws + WS_MOD);
    for (int row = gw; row < M; row += NGW) {
        const int c0 = 8 * F.lane;
        f32x4 v[2][2]; float s = 0.f;
        if (SRCF32) {
            const float* xr = row < MP ? src_p + (size_t)row * D : src_s + (size_t)(row - MP) * D;
#pragma unroll
            for (int j = 0; j < 2; ++j) { v[j][0] = *(const GAS f32x4*)(xr + 512 * j + c0); v[j][1] = *(const GAS f32x4*)(xr + 512 * j + c0 + 4); }
        } else {
#pragma unroll
            for (int j = 0; j < 2; ++j) { const v4u h = *(const GAS v4u*)(hb + (size_t)row * HP + 512 * j + c0);
                v[j][0] = (f32x4){bflo(h.x), bfhi(h.x), bflo(h.y), bfhi(h.y)}; v[j][1] = (f32x4){bflo(h.z), bfhi(h.z), bflo(h.w), bfhi(h.w)}; }
        }
        if (row >= MP && nslab > 0) {
            for (int sl = 0; sl < nslab; ++sl) { const float* sv = slab + ((size_t)sl * MS + (row - MP)) * D + c0;
#pragma unroll
                for (int j = 0; j < 2; ++j) { v[j][0] += *(const GAS f32x4*)(sv + 512 * j); v[j][1] += *(const GAS f32x4*)(sv + 512 * j + 4); } }
        }
#pragma unroll
        for (int j = 0; j < 2; ++j)
#pragma unroll
            for (int e = 0; e < 2; ++e) s += (v[j][e].x * v[j][e].x + v[j][e].y * v[j][e].y) + (v[j][e].z * v[j][e].z + v[j][e].w * v[j][e].w);
        const float rstd = 1.0f / sqrtf(wave_sum(s) * (1.0f / D) + NORM_EPS);
        if (FINAL) {
#pragma unroll
            for (int j = 0; j < 2; ++j)
#pragma unroll
                for (int e = 0; e < 2; ++e) { const f32x4 gv = *(const GAS f32x4*)(g + 512 * j + c0 + 4 * e); *(GAS f32x4*)(y + (size_t)row * D + 512 * j + c0 + 4 * e) = v[j][e] * rstd * gv; }
        } else {
            const int b = row < MP ? (row >> 11) : 8 + (row - MP);
            const float* shp = mod + (size_t)b * NMOD + sh_idx * D + c0;
            const float* scp = mod + (size_t)b * NMOD + sc_idx * D + c0;
            if (row >= MP) {
#pragma unroll
                for (int j = 0; j < 2; ++j) *(GAS v4u*)(hb + (size_t)row * HP + 512 * j + c0) = (v4u){pk2(v[j][0].x, v[j][0].y), pk2(v[j][0].z, v[j][0].w), pk2(v[j][1].x, v[j][1].y), pk2(v[j][1].z, v[j][1].w)}; }
#pragma unroll
            for (int j = 0; j < 2; ++j) { f32x4 n[2];
#pragma unroll
                for (int e = 0; e < 2; ++e) { const f32x4 gv = *(const GAS f32x4*)(g + 512 * j + c0 + 4 * e), sh = *(const GAS f32x4*)(shp + 512 * j + 4 * e), sc = *(const GAS f32x4*)(scp + 512 * j + 4 * e);
                    n[e] = (v[j][e] * rstd * gv) * (sc + 1.0f) + sh; }
                if (SRCF32) *(GAS v2u*)((unsigned char*)xn + (size_t)row * D + 512 * j + c0) = (v2u){pk4f8(n[0].x * pg8::F8_SX, n[0].y * pg8::F8_SX, n[0].z * pg8::F8_SX, n[0].w * pg8::F8_SX), pk4f8(n[1].x * pg8::F8_SX, n[1].y * pg8::F8_SX, n[1].z * pg8::F8_SX, n[1].w * pg8::F8_SX)};
                else *(GAS v4u*)(xn + (size_t)row * D + 512 * j + c0) = (v4u){pk2(n[0].x, n[0].y), pk2(n[0].z, n[0].w), pk2(n[1].x, n[1].y), pk2(n[1].z, n[1].w)}; }
        }
    }
}
#define XB_TMO      128
#define XB_XCNT(j)  (256  + 64 * (j))
#define XB_XSUB(j)  (1280 + 64 * (j))
#define XB_XGEN(j)  (2304 + 64 * (j))
#define XB_TOP      3328
#define XB_TOPGEN   3392
#define XCD_BAR_WORDS 3456
#define XB_SPIN_CAP (1u << 18)

__device__ __forceinline__ unsigned xb_ld(unsigned* p)              { return __hip_atomic_load(p, __ATOMIC_RELAXED, __HIP_MEMORY_SCOPE_AGENT); }
__device__ __forceinline__ unsigned xb_add(unsigned* p, unsigned v) { return __hip_atomic_fetch_add(p, v, __ATOMIC_RELAXED, __HIP_MEMORY_SCOPE_AGENT); }
__device__ __forceinline__ unsigned xb_xcc_id() { return (unsigned)__builtin_amdgcn_s_getreg((3 << 11) | 20) & 0xFu; }
#define XB_SPIN(cond, bar) do { unsigned _sp = 0; while (cond) { __builtin_amdgcn_s_sleep(1); \
    if ((++_sp & 255u) == 0u) { if (xb_ld(&(bar)[XB_TMO])) break; if (_sp > XB_SPIN_CAP) { atomicAdd(&(bar)[XB_TMO], 1u); break; } } } } while (0)

struct XcdBarrier {
    unsigned* bar; unsigned x;
    volatile LAS unsigned* st;
};

__device__ __forceinline__ XcdBarrier xcd_barrier_post(unsigned* bar, volatile LAS unsigned* st) {
    XcdBarrier b; b.bar = bar; b.x = xb_xcc_id(); b.st = st;
    if (threadIdx.x == 0) (void)xb_add(&bar[XB_XCNT(b.x)], 1u);
    return b;
}
__device__ __forceinline__ void xcd_barrier_complete(unsigned* bar, unsigned x, unsigned& nloc, unsigned& nx) {
    const unsigned G = gridDim.x * gridDim.y * gridDim.z;
    unsigned sum, cnt, mine, sp = 0u;
    for (;;) {
        sum = 0u; cnt = 0u; mine = 0u;
#pragma unroll
        for (unsigned j = 0; j < 16; ++j) { const unsigned c = xb_ld(&bar[XB_XCNT(j)]); sum += c; cnt += (c > 0u) ? 1u : 0u; mine = (j == x) ? c : mine; }
        if (sum == G) break;
        __builtin_amdgcn_s_sleep(1);
        if ((++sp & 255u) == 0u) { if (xb_ld(&bar[XB_TMO])) break; if (sp > XB_SPIN_CAP) { atomicAdd(&bar[XB_TMO], 1u); break; } }
    }
    nloc = mine > 0u ? mine : 1u; nx = cnt > 0u ? cnt : 1u;
}

__device__ __forceinline__ void xcd_barrier(const XcdBarrier& b) {
    asm volatile("s_waitcnt vmcnt(0)" ::: "memory");
    __syncthreads();
    if (threadIdx.x == 0) {
        unsigned* bar = b.bar;
        __builtin_amdgcn_s_waitcnt(0);
        unsigned nloc = b.st[0], nx = b.st[1];
        if (nloc == 0u) { xcd_barrier_complete(bar, b.x, nloc, nx); b.st[0] = nloc; b.st[1] = nx; }
        const unsigned old = xb_add(&bar[XB_XSUB(b.x)], 1u);
        const unsigned gen = old / nloc;
        if (old + 1u == (gen + 1u) * nloc) {
            __builtin_amdgcn_fence(__ATOMIC_RELEASE, "agent");
            asm volatile("s_waitcnt vmcnt(0)" ::: "memory");
            const unsigned og = xb_add(&bar[XB_TOP], 1u);
            const unsigned tg = og / nx;
            if (og + 1u == (tg + 1u) * nx) xb_add(&bar[XB_TOPGEN], 1u);
            else XB_SPIN(xb_ld(&bar[XB_TOPGEN]) == tg, bar);
            __builtin_amdgcn_fence(__ATOMIC_ACQUIRE, "agent");
            xb_add(&bar[XB_XGEN(b.x)], 1u);
            asm volatile("s_waitcnt vmcnt(0)" ::: "memory");
        } else {
            XB_SPIN(xb_ld(&bar[XB_XGEN(b.x)]) == gen, bar);
            __builtin_amdgcn_fence(__ATOMIC_ACQUIRE, "agent");
            asm volatile("s_waitcnt vmcnt(0)" ::: "memory");
        }
    }
    __syncthreads();
}

__device__ __forceinline__ void xcd_barrier2(const XcdBarrier& b) {
    asm volatile("s_waitcnt vmcnt(0)" ::: "memory");
    __syncthreads();
    if (threadIdx.x == 0) {
        unsigned* bar = b.bar;
        __builtin_amdgcn_s_waitcnt(0);
        unsigned nloc = b.st[0], nx = b.st[1];
        if (nloc == 0u) { xcd_barrier_complete(bar, b.x, nloc, nx); b.st[0] = nloc; b.st[1] = nx; }
        const unsigned old = xb_add(&bar[XB_XSUB(b.x)], 1u);
        const unsigned gen = old / nloc;
        if (old + 1u == (gen + 1u) * nloc) {
            __builtin_amdgcn_fence(__ATOMIC_RELEASE, "agent");
            asm volatile("s_waitcnt vmcnt(0)" ::: "memory");
            xb_add(&bar[XB_TOP], 1u);
        }
        const unsigned want = (gen + 1u) * nx;
        XB_SPIN(xb_ld(&bar[XB_TOP]) < want, bar);
        __builtin_amdgcn_fence(__ATOMIC_ACQUIRE, "agent");
        asm volatile("s_waitcnt vmcnt(0)" ::: "memory");
    }
    __syncthreads();
}

__device__ __forceinline__ void xcd_barrier3(const XcdBarrier& b) {
    asm volatile("s_waitcnt vmcnt(0)" ::: "memory");
    __syncthreads();
    if (threadIdx.x == 0) {
        unsigned* bar = b.bar;
        __builtin_amdgcn_s_waitcnt(0);
        unsigned nloc = b.st[0], nx = b.st[1];
        if (nloc == 0u) { xcd_barrier_complete(bar, b.x, nloc, nx); b.st[0] = nloc; b.st[1] = nx; }
        const unsigned old = xb_add(&bar[XB_XSUB(b.x)], 1u);
        asm volatile("buffer_inv sc1" ::: "memory");
        const unsigned gen = old / nloc;
        if (old + 1u == (gen + 1u) * nloc) {
            __builtin_amdgcn_fence(__ATOMIC_RELEASE, "agent");
            asm volatile("s_waitcnt vmcnt(0)" ::: "memory");
            xb_add(&bar[XB_TOP], 1u);
        }
        const unsigned want = (gen + 1u) * nx;
        XB_SPIN(xb_ld(&bar[XB_TOP]) < want, bar);
        asm volatile("s_waitcnt vmcnt(0)" ::: "memory");
    }
    __syncthreads();
}

__device__ __forceinline__ void flat_barrier(const XcdBarrier& b) {
    asm volatile("s_waitcnt vmcnt(0)" ::: "memory");
    __syncthreads();
    if (threadIdx.x == 0) {
        unsigned* bar = b.bar;
        __builtin_amdgcn_s_waitcnt(0);
        const unsigned epoch = b.st[2]; b.st[2] = epoch + 1u;
        __builtin_amdgcn_fence(__ATOMIC_RELEASE, "agent");
        asm volatile("s_waitcnt vmcnt(0)" ::: "memory");
        xb_add(&bar[XB_TOP], 1u);
        const unsigned want = (epoch + 1u) * (gridDim.x * gridDim.y * gridDim.z);
        XB_SPIN(xb_ld(&bar[XB_TOP]) < want, bar);
        __builtin_amdgcn_fence(__ATOMIC_ACQUIRE, "agent");
        asm volatile("s_waitcnt vmcnt(0)" ::: "memory");
    }
    __syncthreads();
}

typedef short bf16x8 __attribute__((ext_vector_type(8)));
__device__ __forceinline__ f32x4 mfma_safe(bf16x8 a, bf16x8 b, f32x4 c, int, int, int) {
    const f32x4 d = __builtin_amdgcn_mfma_f32_16x16x32_bf16(a, b, c, 0, 0, 0);
    asm volatile("" :: "v"(d), "v"(a), "v"(b));
    return d;
}
constexpr int RL = 72, RSLOT = 64 * RL * 2;
constexpr int RX_OFF = 16 * RSLOT;
static_assert(RX_OFF + 3 * 1024 <= MISC_OFF, "rwkv2 LDS");
enum { SL_AT = 0, SL_BB = 1, SL_KB = 2, SL_N = 3, SL_NT = 4, SL_MAK = 5, SL_RT = 6, SL_ATT = 7, SL_VT = 8, SL_BHT = 9, SL_KHT = 10, SL_MRB = 11, SL_MRK = 12, SL_RHS = 13, SL_T0 = 14, SL_SB = 15,
       SL_PA = 0, SL_PTA = 1, SL_PB = 2, SL_PTB = 3, SL_T1 = 4, SL_W = 5, SL_UT = 14, SL_WD = 3, SL_AD = 4, SL_GD = 11 };
#define RSL(s) ((LAS bf16*)(F.lds + (s) * RSLOT))
__device__ __forceinline__ bf16x8 ldfrag(const LAS bf16* Mx, int row0, int k0, int lane) { return *(const LAS bf16x8*)(Mx + (row0 + (lane & 15)) * RL + k0 + 8 * (lane >> 4)); }
template <int KS>
__device__ __forceinline__ void mm2(f32x4 (&acc)[2], const LAS bf16* P, const LAS bf16* Q, int p0, int q0, int lane) {
#pragma unroll
    for (int ks = 0; ks < KS; ++ks) {
        const bf16x8 pf = ldfrag(P, p0, 32 * ks, lane), q0f = ldfrag(Q, q0, 32 * ks, lane), q1f = ldfrag(Q, q0 + 16, 32 * ks, lane);
        acc[0] = mfma_safe(q0f, pf, acc[0], 0, 0, 0);
        acc[1] = mfma_safe(q1f, pf, acc[1], 0, 0, 0);
    }
#ifdef MM2_FENCE
    asm volatile("s_nop 15" : "+v"(acc[0]), "+v"(acc[1]));
#endif
}
__device__ __forceinline__ void st_pq(LAS bf16* O, const f32x4 (&v)[2], int p0, int q0, int lane) {
#pragma unroll
    for (int tl = 0; tl < 2; ++tl) *(LAS v2u*)(O + (p0 + (lane & 15)) * RL + q0 + 16 * tl + 4 * (lane >> 4)) = (v2u){pk2(v[tl][0], v[tl][1]), pk2(v[tl][2], v[tl][3])};
}
__device__ __forceinline__ void st_qp(LAS bf16* O, const f32x4 (&v)[2], int p0, int q0, int lane) {
#pragma unroll
    for (int tl = 0; tl < 2; ++tl)
#pragma unroll
        for (int r = 0; r < 4; ++r) O[(q0 + 16 * tl + 4 * (lane >> 4) + r) * RL + p0 + (lane & 15)] = (bf16)f2bf(v[tl][r]);
}
#define RW_BAR() do { asm volatile("s_waitcnt lgkmcnt(0)" ::: "memory"); __builtin_amdgcn_s_barrier(); asm volatile("" ::: "memory"); } while (0)

__device__ __forceinline__ void rwkv_prompt_unit2(Frame& F, int b, int h) {
    const int lane_ = F.lane, w = F.wave;
    const int p0 = 16 * (w >> 1), q0 = 32 * (w & 1);
    const bf16* cur = (const bf16*)(F.a->ws + WS_CUR); bf16* O = (bf16*)(F.a->ws + WS_O);
    const bf16* W2T = (const bf16*)(F.a->ws + WS_LORA); const bf16* A2T = W2T + 512 * 64; const bf16* G2T = A2T + 512 * 64;
    const float* mu = F.a->in[I_MU];
    LAS float* XCH = (LAS float*)(F.lds + RX_OFF); LAS float* LT = XCH + 256; LAS float* XCH2 = LT + 256;
    f32x4 Sreg[2] = {{0.f, 0.f, 0.f, 0.f}, {0.f, 0.f, 0.f, 0.f}};
    { const f32x4 z[2] = {{0.f, 0.f, 0.f, 0.f}, {0.f, 0.f, 0.f, 0.f}}; st_pq(RSL(SL_SB), z, p0, q0, lane_); }
#pragma unroll 1
    for (int ch = 0; ch < SEQ / 64; ++ch) {
        int lane = lane_, tid = F.tid; asm volatile("" : "+v"(lane), "+v"(tid));
        const int li = lane & 15, lq = lane >> 4;
        const size_t row0 = (size_t)b * SEQ + ch * 64;
#pragma unroll
        for (int it = 0; it < 4; ++it) {
            const int item = it * 512 + tid, t = item >> 5, vi = item & 31, col = 1536 + 8 * vi;
            const size_t row = row0 + t;
            const v4u c = *(const GAS v4u*)(cur + row * NSHIFT + col);
            v4u p = (v4u){0u, 0u, 0u, 0u};
            if (ch + t > 0) p = *(const GAS v4u*)(cur + (row - 1) * NSHIFT + col);
            const f32x4 m0 = *(const GAS f32x4*)(mu + col), m1 = *(const GAS f32x4*)(mu + col + 4);
            float x[8];
            { const float c0 = bflo(c.x), c1 = bfhi(c.x), c2 = bflo(c.y), c3 = bfhi(c.y), c4 = bflo(c.z), c5 = bfhi(c.z), c6 = bflo(c.w), c7 = bfhi(c.w);
              x[0] = c0 + m0.x * (bflo(p.x) - c0); x[1] = c1 + m0.y * (bfhi(p.x) - c1); x[2] = c2 + m0.z * (bflo(p.y) - c2); x[3] = c3 + m0.w * (bfhi(p.y) - c3);
              x[4] = c4 + m1.x * (bflo(p.z) - c4); x[5] = c5 + m1.y * (bfhi(p.z) - c5); x[6] = c6 + m1.z * (bflo(p.w) - c6); x[7] = c7 + m1.w * (bfhi(p.w) - c7); }
            if (vi < 8) {
#pragma unroll
                for (int i = 0; i < 8; ++i) x[i] = tanhf_(x[i]);
                *(LAS v4u*)(RSL(SL_WD) + t * RL + 8 * vi) = (v4u){pk2(x[0], x[1]), pk2(x[2], x[3]), pk2(x[4], x[5]), pk2(x[6], x[7])};
            } else if (vi < 16) {
                *(LAS v4u*)(RSL(SL_AD) + t * RL + 8 * (vi - 8)) = (v4u){pk2(x[0], x[1]), pk2(x[2], x[3]), pk2(x[4], x[5]), pk2(x[6], x[7])};
            } else {
#pragma unroll
                for (int i = 0; i < 8; ++i) x[i] = sigmoidf_(x[i]);
                *(LAS v4u*)(RSL(SL_GD) + t * 136 + 8 * (vi - 16)) = (v4u){pk2(x[0], x[1]), pk2(x[2], x[3]), pk2(x[4], x[5]), pk2(x[6], x[7])};
            }
        }
        f32x4 rr[2], kr[2], vr[2];
        {
            const size_t row = row0 + p0 + li; const bool hasprev = (ch + p0 + li) > 0;
#pragma unroll
            for (int tl = 0; tl < 2; ++tl) {
                const int jc = 64 * h + q0 + 16 * tl + 4 * lq;
#pragma unroll
                for (int s = 0; s < 3; ++s) {
                    const int col = 512 * s + jc;
                    const v2u c = *(const GAS v2u*)(cur + row * NSHIFT + col);
                    v2u p = (v2u){0u, 0u};
                    if (hasprev) p = *(const GAS v2u*)(cur + (row - 1) * NSHIFT + col);
                    const f32x4 m = *(const GAS f32x4*)(mu + col);
                    const float c0 = bflo(c.x), c1 = bfhi(c.x), c2 = bflo(c.y), c3 = bfhi(c.y);
                    const f32x4 x = (f32x4){c0 + m.x * (bflo(p.x) - c0), c1 + m.y * (bfhi(p.x) - c1), c2 + m.z * (bflo(p.y) - c2), c3 + m.w * (bfhi(p.y) - c3)};
                    if (s == 0) rr[tl] = x; else if (s == 1) kr[tl] = x; else vr[tl] = x;
                }
            }
        }
        RW_BAR();
        f32x4 aw[2], aa[2], ag[2] = {{0.f, 0.f, 0.f, 0.f}, {0.f, 0.f, 0.f, 0.f}};
#pragma unroll
        for (int tl = 0; tl < 2; ++tl) { const int jc = 64 * h + q0 + 16 * tl + 4 * lq; aw[tl] = *(const GAS f32x4*)(F.a->in[I_W0] + jc); aa[tl] = *(const GAS f32x4*)(F.a->in[I_A0] + jc); }
        {
#pragma unroll
            for (int ks = 0; ks < 2; ++ks) {
                const bf16x8 pw = ldfrag(RSL(SL_WD), p0, 32 * ks, lane), pa = ldfrag(RSL(SL_AD), p0, 32 * ks, lane);
#pragma unroll
                for (int tl = 0; tl < 2; ++tl) {
                    const size_t wr = (size_t)(64 * h + q0 + 16 * tl + li) * 64 + 32 * ks + 8 * lq;
                    const bf16x8 qw = *(const GAS bf16x8*)(W2T + wr), qa = *(const GAS bf16x8*)(A2T + wr);
                    aw[tl] = mfma_safe(qw, pw, aw[tl], 0, 0, 0);
                    aa[tl] = mfma_safe(qa, pa, aa[tl], 0, 0, 0);
                }
            }
#pragma unroll
            for (int ks = 0; ks < 4; ++ks) {
                const bf16x8 pg = *(const LAS bf16x8*)(RSL(SL_GD) + (p0 + li) * 136 + 32 * ks + 8 * lq);
#pragma unroll
                for (int tl = 0; tl < 2; ++tl) {
                    const bf16x8 qg = *(const GAS bf16x8*)(G2T + (size_t)(64 * h + q0 + 16 * tl + li) * 128 + 32 * ks + 8 * lq);
                    ag[tl] = mfma_safe(qg, pg, ag[tl], 0, 0, 0);
                }
            }
        }
        f32x4 ldv[2], alv[2], kkv[2], kpv[2], Lc[2];
        float ss = 0.f, bon = 0.f;
#pragma unroll
        for (int tl = 0; tl < 2; ++tl) {
            const int jc = 64 * h + q0 + 16 * tl + 4 * lq;
            const f32x4 c_kk = *(const GAS f32x4*)(F.a->in[I_KK] + jc), c_ka = *(const GAS f32x4*)(F.a->in[I_KA] + jc), c_rk = *(const GAS f32x4*)(F.a->in[I_RK] + jc);
#pragma unroll
            for (int r = 0; r < 4; ++r) {
                const float wv = -softplusf_(-aw[tl][r]) - 0.5f;
                ldv[tl][r] = -__expf(wv);
                alv[tl][r] = sigmoidf_(aa[tl][r]);
                kkv[tl][r] = kr[tl][r] * c_kk[r]; ss += kkv[tl][r] * kkv[tl][r];
                kpv[tl][r] = kr[tl][r] * (1.0f + (alv[tl][r] - 1.0f) * c_ka[r]);
                bon += rr[tl][r] * kpv[tl][r] * c_rk[r];
                float x = ldv[tl][r];
#pragma unroll
                for (int o = 1; o < 16; o <<= 1) { const float y = __shfl_up(x, o, 16); if (li >= o) x += y; }
                Lc[tl][r] = x;
            }
        }
        ss += __shfl_xor(ss, 16); ss += __shfl_xor(ss, 32); bon += __shfl_xor(bon, 16); bon += __shfl_xor(bon, 32);
        if (lane < 16) { XCH[(w * 16 + li) * 2] = ss; XCH[(w * 16 + li) * 2 + 1] = bon; }
        if (li == 15) {
#pragma unroll
            for (int tl = 0; tl < 2; ++tl) *(LAS f32x4*)(LT + (w >> 1) * 64 + q0 + 16 * tl + 4 * lq) = Lc[tl];
        }
        RW_BAR();
        {
            const int wp = w ^ 1; ss += XCH[(wp * 16 + li) * 2]; bon += XCH[(wp * 16 + li) * 2 + 1];
        }
        const float inv = 1.0f / fmaxf(sqrtf(ss), 1e-12f);
        f32x4 gC[2];
#pragma unroll
        for (int tl = 0; tl < 2; ++tl) {
            const int jq = q0 + 16 * tl + 4 * lq;
            f32x4 off = {0.f, 0.f, 0.f, 0.f}, tot = {0.f, 0.f, 0.f, 0.f};
#pragma unroll
            for (int pb = 0; pb < 4; ++pb) { const f32x4 x = *(const LAS f32x4*)(LT + pb * 64 + jq); tot += x; if (pb < (w >> 1)) off += x; }
            f32x4 at, rt, bb, kb, bh, kh;
#pragma unroll
            for (int r = 0; r < 4; ++r) {
                const float Lt = Lc[tl][r] + off[r], gt = __expf(Lt), gp = __expf(Lt - ldv[tl][r]), gi = __expf(-Lt), gh = __expf(tot[r] - Lt);
                gC[tl][r] = __expf(tot[r]);
                const float kn = kkv[tl][r] * inv, bv = kn * alv[tl][r];
                at[r] = -kn * gp; rt[r] = rr[tl][r] * gt; bb[r] = bv * gi; kb[r] = kpv[tl][r] * gi; bh[r] = bv * gh; kh[r] = kpv[tl][r] * gh;
            }
            const int ro = (p0 + li) * RL + jq;
            *(LAS v2u*)(RSL(SL_AT) + ro) = (v2u){pk2(at[0], at[1]), pk2(at[2], at[3])};
            *(LAS v2u*)(RSL(SL_RT) + ro) = (v2u){pk2(rt[0], rt[1]), pk2(rt[2], rt[3])};
            *(LAS v2u*)(RSL(SL_BB) + ro) = (v2u){pk2(bb[0], bb[1]), pk2(bb[2], bb[3])};
            *(LAS v2u*)(RSL(SL_KB) + ro) = (v2u){pk2(kb[0], kb[1]), pk2(kb[2], kb[3])};
#pragma unroll
            for (int r = 0; r < 4; ++r) { const int co = (jq + r) * RL + p0 + li;
                RSL(SL_ATT)[co] = (bf16)f2bf(at[r]); RSL(SL_BHT)[co] = (bf16)f2bf(bh[r]); RSL(SL_KHT)[co] = (bf16)f2bf(kh[r]); RSL(SL_VT)[co] = (bf16)f2bf(vr[tl][r]); }
        }
        RW_BAR();
        f32x4 Treg[2];
        {
            f32x4 n_[2] = {{0.f, 0.f, 0.f, 0.f}, {0.f, 0.f, 0.f, 0.f}}, mak[2] = {{0.f, 0.f, 0.f, 0.f}, {0.f, 0.f, 0.f, 0.f}}, mrb[2] = {{0.f, 0.f, 0.f, 0.f}, {0.f, 0.f, 0.f, 0.f}}, mrk[2] = {{0.f, 0.f, 0.f, 0.f}, {0.f, 0.f, 0.f, 0.f}};
            mm2<2>(n_, RSL(SL_AT), RSL(SL_BB), p0, q0, lane); mm2<2>(mak, RSL(SL_AT), RSL(SL_KB), p0, q0, lane);
            mm2<2>(mrb, RSL(SL_RT), RSL(SL_BB), p0, q0, lane); mm2<2>(mrk, RSL(SL_RT), RSL(SL_KB), p0, q0, lane);
#pragma unroll
            for (int tl = 0; tl < 2; ++tl)
#pragma unroll
                for (int r = 0; r < 4; ++r) { const int t = p0 + li, s = q0 + 16 * tl + 4 * lq + r;
                    if (!(t > s)) { n_[tl][r] = 0.f; mak[tl][r] = 0.f; } if (!(t >= s)) { mrb[tl][r] = 0.f; mrk[tl][r] = 0.f; }
                    Treg[tl][r] = n_[tl][r] + (t == s ? 1.0f : 0.0f); }
            st_pq(RSL(SL_N), n_, p0, q0, lane); st_qp(RSL(SL_NT), n_, p0, q0, lane); st_pq(RSL(SL_MAK), mak, p0, q0, lane);
            st_pq(RSL(SL_MRB), mrb, p0, q0, lane); st_pq(RSL(SL_MRK), mrk, p0, q0, lane); st_pq(RSL(SL_T0), Treg, p0, q0, lane);
        }
        RW_BAR();
        {
            f32x4 pa[2] = {{0.f, 0.f, 0.f, 0.f}, {0.f, 0.f, 0.f, 0.f}}, rh[2] = {{0.f, 0.f, 0.f, 0.f}, {0.f, 0.f, 0.f, 0.f}};
            mm2<2>(pa, RSL(SL_N), RSL(SL_NT), p0, q0, lane); mm2<2>(rh, RSL(SL_VT), RSL(SL_MAK), p0, q0, lane);
            st_pq(RSL(SL_PA), pa, p0, q0, lane); st_qp(RSL(SL_PTA), pa, p0, q0, lane); st_pq(RSL(SL_RHS), rh, p0, q0, lane);
        }
        RW_BAR();
        {
            f32x4 pb[2] = {{0.f, 0.f, 0.f, 0.f}, {0.f, 0.f, 0.f, 0.f}};
            mm2<2>(Treg, RSL(SL_T0), RSL(SL_PTA), p0, q0, lane); mm2<2>(pb, RSL(SL_PA), RSL(SL_PTA), p0, q0, lane);
            st_pq(RSL(SL_T1), Treg, p0, q0, lane); st_pq(RSL(SL_PB), pb, p0, q0, lane); st_qp(RSL(SL_PTB), pb, p0, q0, lane);
        }
        RW_BAR();
        {
            f32x4 pa[2] = {{0.f, 0.f, 0.f, 0.f}, {0.f, 0.f, 0.f, 0.f}};
            mm2<2>(Treg, RSL(SL_T1), RSL(SL_PTB), p0, q0, lane); mm2<2>(pa, RSL(SL_PB), RSL(SL_PTB), p0, q0, lane);
            st_pq(RSL(SL_T0), Treg, p0, q0, lane); st_pq(RSL(SL_PA), pa, p0, q0, lane); st_qp(RSL(SL_PTA), pa, p0, q0, lane);
        }
        RW_BAR();
        {
            f32x4 pb[2] = {{0.f, 0.f, 0.f, 0.f}, {0.f, 0.f, 0.f, 0.f}};
            mm2<2>(Treg, RSL(SL_T0), RSL(SL_PTA), p0, q0, lane); mm2<2>(pb, RSL(SL_PA), RSL(SL_PTA), p0, q0, lane);
            st_pq(RSL(SL_T1), Treg, p0, q0, lane); st_pq(RSL(SL_PB), pb, p0, q0, lane); st_qp(RSL(SL_PTB), pb, p0, q0, lane);
        }
        RW_BAR();
        {
            f32x4 pt[2] = {{0.f, 0.f, 0.f, 0.f}, {0.f, 0.f, 0.f, 0.f}};
            mm2<2>(Treg, RSL(SL_T1), RSL(SL_PTB), p0, q0, lane); mm2<2>(pt, RSL(SL_PTB), RSL(SL_PB), p0, q0, lane);
            st_pq(RSL(SL_T0), Treg, p0, q0, lane); st_pq(RSL(SL_PTA), pt, p0, q0, lane);
        }
        RW_BAR();
        {
            mm2<2>(Treg, RSL(SL_T0), RSL(SL_PTA), p0, q0, lane);
            st_pq(RSL(SL_T1), Treg, p0, q0, lane);
        }
        RW_BAR();
        {
            f32x4 wv[2] = {{0.f, 0.f, 0.f, 0.f}, {0.f, 0.f, 0.f, 0.f}};
            mm2<2>(wv, RSL(SL_T1), RSL(SL_ATT), p0, q0, lane);
            st_pq(RSL(SL_W), wv, p0, q0, lane);
        }
        RW_BAR();
        f32x4 Yreg[2] = {{0.f, 0.f, 0.f, 0.f}, {0.f, 0.f, 0.f, 0.f}};
        {
            f32x4 ut[2] = {{0.f, 0.f, 0.f, 0.f}, {0.f, 0.f, 0.f, 0.f}};
            mm2<2>(ut, RSL(SL_SB), RSL(SL_W), p0, q0, lane); mm2<2>(ut, RSL(SL_RHS), RSL(SL_T1), p0, q0, lane);
            mm2<2>(Yreg, RSL(SL_RT), RSL(SL_SB), p0, q0, lane);
            st_pq(RSL(SL_UT), ut, p0, q0, lane);
        }
        RW_BAR();
        {
#pragma unroll
            for (int tl = 0; tl < 2; ++tl) Sreg[tl] = Sreg[tl] * gC[tl];
            mm2<2>(Sreg, RSL(SL_UT), RSL(SL_BHT), p0, q0, lane); mm2<2>(Sreg, RSL(SL_VT), RSL(SL_KHT), p0, q0, lane);
            mm2<2>(Yreg, RSL(SL_MRB), RSL(SL_UT), p0, q0, lane); mm2<2>(Yreg, RSL(SL_MRK), RSL(SL_VT), p0, q0, lane);
            st_pq(RSL(SL_SB), Sreg, p0, q0, lane);
        }
        {
            float s = 0.f;
#pragma unroll
            for (int tl = 0; tl < 2; ++tl) s += (Yreg[tl][0] + Yreg[tl][1]) + (Yreg[tl][2] + Yreg[tl][3]);
            s += __shfl_xor(s, 16); s += __shfl_xor(s, 32);
            const float mw = s * (1.0f / 32.0f); float q = 0.f;
#pragma unroll
            for (int tl = 0; tl < 2; ++tl)
#pragma unroll
                for (int r = 0; r < 4; ++r) { const float d = Yreg[tl][r] - mw; q += d * d; }
            q += __shfl_xor(q, 16); q += __shfl_xor(q, 32);
            if (lane < 16) { XCH2[(w * 16 + li) * 2] = mw; XCH2[(w * 16 + li) * 2 + 1] = q; }
            RW_BAR();
            const float mo = XCH2[((w ^ 1) * 16 + li) * 2], qo = XCH2[((w ^ 1) * 16 + li) * 2 + 1];
            const float mean = 0.5f * (mw + mo), dm = mw - mo, m2 = q + qo + 16.0f * dm * dm;
            const float rstd = 1.0f / sqrtf(m2 * (1.0f / 64.0f) + GN_EPS);
#pragma unroll
            for (int tl = 0; tl < 2; ++tl) {
                const int jc = 64 * h + q0 + 16 * tl + 4 * lq;
                const f32x4 c_lnw = *(const GAS f32x4*)(F.a->in[I_LNW] + jc), c_lnb = *(const GAS f32x4*)(F.a->in[I_LNB] + jc);
                float o[4];
#pragma unroll
                for (int r = 0; r < 4; ++r) o[r] = ((Yreg[tl][r] - mean) * rstd * c_lnw[r] + c_lnb[r] + bon * vr[tl][r]) * ag[tl][r];
                *(GAS v2u*)(O + (row0 + p0 + li) * 512 + 64 * h + q0 + 16 * tl + 4 * lq) = (v2u){pk2(o[0], o[1]), pk2(o[2], o[3])};
            }
        }
        RW_BAR();
    }
    {
        const int li = lane_ & 15, lq = lane_ >> 4;
        float* so = F.a->out + O_WKV_P + ((size_t)(b * 8 + h) * 64 + p0 + li) * 64 + q0 + 4 * lq;
#pragma unroll
        for (int tl = 0; tl < 2; ++tl) *(GAS f32x4*)(so + 16 * tl) = Sreg[tl];
    }
}

__device__ __forceinline__ void s5_par_prologue(Frame& F) {
    float* par = (float*)(F.a->ws + WS_S5PAR);
    for (int i = F.bid * 512 + F.tid; i < 2048; i += F.G * 512) {
        const int g = i >> 6;
        const double dt = exp((double)F.a->in[I_LOGDT][g]);
        const double lr = (double)F.a->in[I_LAMRE][i], li = (double)F.a->in[I_LAMIM][i];
        const double mag = exp(lr * dt), ang = li * dt;
        const double lbr = mag * cos(ang), lbi = mag * sin(ang);
        const double den = lr * lr + li * li, numr = lbr - 1.0;
        const double kr = (numr * lr + lbi * li) / den, ki = (lbi * lr - numr * li) / den;
        double pr = lbr, pi = lbi;
#pragma unroll
        for (int s = 0; s < 8; ++s) { const double t = pr * pr - pi * pi; pi = 2.0 * pr * pi; pr = t; }
        *(GAS f32x4*)(par + i * 8) = (f32x4){(float)lbr, (float)lbi, (float)kr, (float)ki};
        *(GAS f32x4*)(par + i * 8 + 4) = (f32x4){(float)pr, (float)pi, 0.f, 0.f};
    }
}
constexpr int S5_BT = 20, S5_XS = 136;
constexpr int S5_WAVE_BYTES = 128 * S5_BT * 4 + 16 * S5_XS * 2;
static_assert(4096 + 8 * S5_WAVE_BYTES <= MISC_OFF, "s5 LDS");
__device__ __forceinline__ void s5_prompt_unit2(Frame& F, int b0, int g, int bstep) {
    const int lane = F.lane, w = F.wave, li = lane & 15, lq = lane >> 4;
    LAS float* ERE = (LAS float*)F.lds;
    LAS float* EIM = ERE + 512;
    LAS float* BUT = (LAS float*)(F.lds + 4096 + w * S5_WAVE_BYTES);
    LAS bf16* X = (LAS bf16*)(BUT + 128 * S5_BT);
    const bf16* s5in = (const bf16*)(F.a->ws + WS_S5IN); bf16* Z = (bf16*)(F.a->ws + WS_Z);
    const float* par = (const float*)(F.a->ws + WS_S5PAR) + (size_t)g * 64 * 8;
    bf16x8 bfr[8];
#pragma unroll
    for (int k = 0; k < 4; ++k) {
        const int n = 16 * k + li;
        const f32x4 pn = *(const GAS f32x4*)(par + n * 8);
        float re[8], im[8];
        if (lq < 2) {
            const float* br = F.a->in[I_BRE] + (size_t)(g * 64 + n) * 16 + 8 * lq; const float* bi = F.a->in[I_BIM] + (size_t)(g * 64 + n) * 16 + 8 * lq;
#pragma unroll
            for (int j = 0; j < 8; ++j) { const float x = br[j], y = bi[j]; re[j] = pn.z * x - pn.w * y; im[j] = pn.z * y + pn.w * x; }
        } else {
#pragma unroll
            for (int j = 0; j < 8; ++j) { re[j] = 0.f; im[j] = 0.f; }
        }
        const v4u r4 = (v4u){cvtpk(re[0], re[1]), cvtpk(re[2], re[3]), cvtpk(re[4], re[5]), cvtpk(re[6], re[7])};
        const v4u i4 = (v4u){cvtpk(im[0], im[1]), cvtpk(im[2], im[3]), cvtpk(im[4], im[5]), cvtpk(im[6], im[7])};
        bfr[k] = __builtin_bit_cast(bf16x8, r4); bfr[k + 4] = __builtin_bit_cast(bf16x8, i4);
    }
    bf16x8 cfr[4];
#pragma unroll
    for (int ks = 0; ks < 4; ++ks) {
        const int n0 = 16 * ks + 4 * lq;
        const f32x4 cr = *(const GAS f32x4*)(F.a->in[I_CRE] + (size_t)(g * 16 + li) * 64 + n0), ci = *(const GAS f32x4*)(F.a->in[I_CIM] + (size_t)(g * 16 + li) * 64 + n0);
        const v4u c4 = (v4u){cvtpk(cr.x, -ci.x), cvtpk(cr.y, -ci.y), cvtpk(cr.z, -ci.z), cvtpk(cr.w, -ci.w)};
        cfr[ks] = __builtin_bit_cast(bf16x8, c4);
    }
    const f32x4 pl = *(const GAS f32x4*)(par + lane * 8);
    const float lbr = pl.x, lbi = pl.y;
    const f32x4 dco = *(const GAS f32x4*)(F.a->in[I_S5D] + 16 * g + 4 * lq);
#pragma unroll 1
    for (int b = b0; b < 8; b += bstep) {
    const size_t rowbase = (size_t)b * SEQ + 256 * w;
    float xr = 0.f, xi = 0.f;
#pragma unroll 1
    for (int pass = 0; pass < 2; ++pass) {
        const bf16* ubase = s5in + (rowbase + li) * 512 + 16 * g;
        v4u unA = *(const GAS v4u*)(ubase + 8 * (lq & 1)), unB = *(const GAS v4u*)(ubase + 16 * 512 + 8 * (lq & 1));
        v2u uuA = *(const GAS v2u*)(ubase + 4 * lq), uuB = *(const GAS v2u*)(ubase + 16 * 512 + 4 * lq);
        auto blockf = [&](v4u& un, v2u& uun, const int blk) {
            const v4u ul = un; const v2u uu = uun;
            const v4u ua = lq < 2 ? ul : (v4u){0u, 0u, 0u, 0u};
            { const int bn = blk + 2 < 16 ? blk + 2 : 15; un = *(const GAS v4u*)(ubase + (size_t)bn * (16 * 512) + 8 * (lq & 1)); uun = *(const GAS v2u*)(ubase + (size_t)bn * (16 * 512) + 4 * lq); }
            const bf16x8 uf = __builtin_bit_cast(bf16x8, ua);
            f32x4 dd[8];
#pragma unroll
            for (int k = 0; k < 8; ++k) dd[k] = mfma_safe(uf, bfr[k], (f32x4){0.f, 0.f, 0.f, 0.f}, 0, 0, 0);
            asm volatile("s_nop 15\n\ts_nop 15" : "+v"(dd[0]), "+v"(dd[1]), "+v"(dd[2]), "+v"(dd[3]), "+v"(dd[4]), "+v"(dd[5]), "+v"(dd[6]), "+v"(dd[7]) : "v"(ua));
#pragma unroll
            for (int k = 0; k < 8; ++k) *(LAS f32x4*)(BUT + (16 * k + li) * S5_BT + 4 * lq) = dd[k];
            LDS_WAIT();
            f32x4 br_[4], bi_[4];
#pragma unroll
            for (int j = 0; j < 4; ++j) { br_[j] = *(const LAS f32x4*)(BUT + lane * S5_BT + 4 * j); bi_[j] = *(const LAS f32x4*)(BUT + (64 + lane) * S5_BT + 4 * j); }
            if (pass == 0) {
#pragma unroll
                for (int t = 0; t < 16; ++t) { const float bur = br_[t >> 2][t & 3], bui = bi_[t >> 2][t & 3];
                    const float nr = __builtin_fmaf(lbr, xr, __builtin_fmaf(-lbi, xi, bur)), ni = __builtin_fmaf(lbr, xi, __builtin_fmaf(lbi, xr, bui)); xr = nr; xi = ni; }
            } else {
#pragma unroll
                for (int t = 0; t < 16; ++t) { const float bur = br_[t >> 2][t & 3], bui = bi_[t >> 2][t & 3];
                    const float nr = __builtin_fmaf(lbr, xr, __builtin_fmaf(-lbi, xi, bur)), ni = __builtin_fmaf(lbr, xi, __builtin_fmaf(lbi, xr, bui)); xr = nr; xi = ni;
                    *(LAS unsigned*)(X + t * S5_XS + 2 * lane) = cvtpk(xr, xi); }
                LDS_WAIT();
                f32x4 y = {0.f, 0.f, 0.f, 0.f}; asm volatile("" : "+v"(y));
#pragma unroll
                for (int ks = 0; ks < 4; ++ks) { const bf16x8 xf = *(const LAS bf16x8*)(X + li * S5_XS + 32 * ks + 8 * lq);
                    y = mfma_safe(cfr[ks], xf, y, 0, 0, 0); }
                const size_t roz = (rowbase + blk * 16 + li) * OZP + 16 * g + 4 * lq;
                const float z0 = gelu_tanh(y[0] + dco.x * bflo(uu.x)), z1 = gelu_tanh(y[1] + dco.y * bfhi(uu.x)), z2 = gelu_tanh(y[2] + dco.z * bflo(uu.y)), z3 = gelu_tanh(y[3] + dco.w * bfhi(uu.y));
                *(GAS v2u*)(Z + roz) = (v2u){cvtpk(z0, z1), cvtpk(z2, z3)};
            }
            LDS_WAIT();
        };
#pragma unroll 1
        for (int blk = 0; blk < 16; blk += 2) { blockf(unA, uuA, blk); blockf(unB, uuB, blk + 1); }
        if (pass == 0) {
            ERE[w * 64 + lane] = xr; EIM[w * 64 + lane] = xi;
            __syncthreads();
            const f32x4 p2 = *(const GAS f32x4*)(par + lane * 8 + 4);
            float cr = 0.f, ci = 0.f;
            for (int ww = 0; ww < w; ++ww) { const float er = ERE[ww * 64 + lane], ei = EIM[ww * 64 + lane]; const float t = p2.x * cr - p2.y * ci + er; ci = p2.x * ci + p2.y * cr + ei; cr = t; }
            xr = cr; xi = ci;
        }
    }
    if (w == 7) { F.a->out[O_S5RE_P + (size_t)(b * 32 + g) * 64 + lane] = xr; F.a->out[O_S5IM_P + (size_t)(b * 32 + g) * 64 + lane] = xi; }
    __syncthreads();
    }
}

constexpr size_t WS_RQ = WS_GATES, WS_BON = WS_END;
static_assert(WS_RQ + 64 * MiB <= WS_GATES + (size_t)MP * 2048 * 2 && WS_BON + 2048 * 64 * 4 <= 256 * MiB, "rwkv intermediates");
constexpr int A_PERS = 13 * RSLOT;
constexpr int A_XOFF = A_PERS + 2 * 64 * RL * 2 + 64 * 136 * 2;
static_assert(A_XOFF + 3 * 1024 <= MISC_OFF, "rwkv phase A LDS");
enum { A_AT = 0, A_BB = 1, A_KB = 2, A_ND = 3, A_N = 4, A_MAK = 5, A_RT = 6, A_ATT = 7, A_VT = 8, A_MRB = 9, A_MRK = 10, A_RHS = 11, A_TR = 12,
       A_BHT = 0, A_KHT = 1, A_WT = 2, A_ULT = 6 };
__device__ __forceinline__ float fsig(float x) { return __builtin_amdgcn_rcpf(1.0f + __expf(-x)); }
__device__ __forceinline__ float ftanh(float x) { return 1.0f - 2.0f * __builtin_amdgcn_rcpf(__expf(2.0f * x) + 1.0f); }
__device__ __forceinline__ void st_pq_h(LAS bf16* O, const f32x4 (&v)[2], int p0, int q0, int lane) {
#pragma unroll
    for (int tl = 0; tl < 2; ++tl) *(LAS v2u*)(O + (p0 + (lane & 15)) * RL + q0 + 16 * tl + 4 * (lane >> 4)) = (v2u){cvtpk(v[tl][0], v[tl][1]), cvtpk(v[tl][2], v[tl][3])};
}
__device__ __forceinline__ void st_qp_h(LAS bf16* O, const f32x4 (&v)[2], int p0, int q0, int lane) {
#pragma unroll
    for (int tl = 0; tl < 2; ++tl) { const unsigned a = cvtpk(v[tl][0], v[tl][1]), b = cvtpk(v[tl][2], v[tl][3]);
        LAS bf16* o = O + (q0 + 16 * tl + 4 * (lane >> 4)) * RL + p0 + (lane & 15);
        o[0] = (bf16)(a & 0xffffu); o[RL] = (bf16)(a >> 16); o[2 * RL] = (bf16)(b & 0xffffu); o[3 * RL] = (bf16)(b >> 16); }
}
__device__ __forceinline__ int swz_off(int r, int c) { return r * 64 + ((((c >> 3) ^ (r & 7))) << 3) + (c & 7); }
__device__ __forceinline__ void st_glob(bf16* G, const f32x4 (&v)[2], int p0, int q0, int lane) {
#pragma unroll
    for (int tl = 0; tl < 2; ++tl) *(GAS v2u*)(G + swz_off(p0 + (lane & 15), q0 + 16 * tl + 4 * (lane >> 4))) = (v2u){cvtpk(v[tl][0], v[tl][1]), cvtpk(v[tl][2], v[tl][3])};
}
#define ASL(s) ((LAS bf16*)(F.lds + (s) * RSLOT))
#define ZERO2 {{0.f, 0.f, 0.f, 0.f}, {0.f, 0.f, 0.f, 0.f}}

constexpr int DL = 24;
__device__ __forceinline__ bf16x8 ld16(const LAS bf16* Mx, int lane) {
    const v4u z = {0u, 0u, 0u, 0u}; const v4u v = *(const LAS v4u*)(Mx + (lane & 15) * DL + 8 * ((lane >> 4) & 1));
    return __builtin_bit_cast(bf16x8, (lane >> 4) < 2 ? v : z);
}
__device__ __forceinline__ void st16_pq(LAS bf16* O, const f32x4& v, int lane) { *(LAS v2u*)(O + (lane & 15) * DL + 4 * (lane >> 4)) = (v2u){cvtpk(v[0], v[1]), cvtpk(v[2], v[3])}; }
__device__ __forceinline__ void st16_qp(LAS bf16* O, const f32x4& v, int lane) { const unsigned a = cvtpk(v[0], v[1]), b = cvtpk(v[2], v[3]);
    LAS bf16* o = O + (4 * (lane >> 4)) * DL + (lane & 15); o[0] = (bf16)(a & 0xffffu); o[DL] = (bf16)(a >> 16); o[2 * DL] = (bf16)(b & 0xffffu); o[3 * DL] = (bf16)(b >> 16); }
struct APre { v2u c[2][3], p[2][3]; };
__device__ __forceinline__ void rwkvA_loadrkv(APre& P, const bf16* cur, const float* mu, size_t row, size_t row0b, bool hasprev, int h, int q0, int lq) {
#pragma unroll
    for (int tl = 0; tl < 2; ++tl)
#pragma unroll
        for (int s = 0; s < 3; ++s) { const int col = 512 * s + 64 * h + q0 + 16 * tl + 4 * lq;
            P.c[tl][s] = *(const GAS v2u*)(cur + row * NSHIFT + col);
            const v2u pv = *(const GAS v2u*)(cur + (row0b - 1) * NSHIFT + col);
            P.p[tl][s] = hasprev ? pv : (v2u){0u, 0u}; }
}
__device__ __forceinline__ float rows_sum(float x) {
    float a = x, b = x;
    asm volatile("s_nop 1\n\tv_permlane16_swap_b32 %0, %1\n\ts_nop 1" : "+v"(a), "+v"(b));
    a += b; b = a;
    asm volatile("s_nop 1\n\tv_permlane32_swap_b32 %0, %1\n\ts_nop 1" : "+v"(a), "+v"(b));
    return a + b;
}
struct HC { f32x4 mu[2][3], w0[2], a0[2], ckk[2], cka[2], crk[2]; bf16x8 qw[2][2], qa[2][2], qg[4][2]; };
template <int PART>
__device__ __forceinline__ void rwkvA_loadhc(HC& C, Frame& F, const float* mu, const bf16* W2T, const bf16* A2T, const bf16* G2T, int h, int q0, int lane) {
    const int li = lane & 15, lq = lane >> 4;
#pragma unroll
    for (int tl = 0; tl < 2; ++tl) {
        const int jc = 64 * h + q0 + 16 * tl + 4 * lq;
        if (PART & 1) {
#pragma unroll
            for (int s = 0; s < 3; ++s) C.mu[tl][s] = *(const GAS f32x4*)(mu + 512 * s + jc);
            C.w0[tl] = *(const GAS f32x4*)(F.a->in[I_W0] + jc); C.a0[tl] = *(const GAS f32x4*)(F.a->in[I_A0] + jc);
            C.ckk[tl] = *(const GAS f32x4*)(F.a->in[I_KK] + jc); C.cka[tl] = *(const GAS f32x4*)(F.a->in[I_KA] + jc); C.crk[tl] = *(const GAS f32x4*)(F.a->in[I_RK] + jc);
        }
        if (PART & 2) {
            const size_t wrow = (size_t)(64 * h + q0 + 16 * tl + li);
#pragma unroll
            for (int ks = 0; ks < 2; ++ks) { C.qw[ks][tl] = *(const GAS bf16x8*)(W2T + wrow * 64 + 32 * ks + 8 * lq); C.qa[ks][tl] = *(const GAS bf16x8*)(A2T + wrow * 64 + 32 * ks + 8 * lq); }
#pragma unroll
            for (int ks = 0; ks < 4; ++ks) C.qg[ks][tl] = *(const GAS bf16x8*)(G2T + wrow * 128 + 32 * ks + 8 * lq);
        }
    }
}
__device__ __forceinline__ void rwkvA_unit(Frame& F, int b, int ch) {
    const int w = F.wave, lane0 = F.lane, tid0 = F.tid;
    const int p0 = 16 * (w >> 1), q0 = 32 * (w & 1);
    const bf16* cur = (const bf16*)(F.a->ws + WS_CUR); bf16* O = (bf16*)(F.a->ws + WS_O);
    const bf16* W2T = (const bf16*)(F.a->ws + WS_LORA); const bf16* A2T = W2T + 512 * 64; const bf16* G2T = A2T + 512 * 64;
    bf16* RQ = (bf16*)(F.a->ws + WS_RQ); float* BONB = (float*)(F.a->ws + WS_BON);
    const float* mu = F.a->in[I_MU];
    LAS bf16* WD = (LAS bf16*)(F.lds + A_PERS); LAS bf16* AD = WD + 64 * RL; LAS bf16* GD = AD + 64 * RL;
    LAS float* XCH = (LAS float*)(F.lds + A_XOFF); LAS float* LT = XCH + 256;
    const size_t row0 = (size_t)b * SEQ + ch * 64;
#pragma unroll
    for (int it = 0; it < 4; ++it) {
        const int item = it * 512 + tid0, t = item >> 5, vi = item & 31, col = 1536 + 8 * vi;
        const size_t row = row0 + t;
        const v4u c = *(const GAS v4u*)(cur + row * NSHIFT + col);
        v4u p = *(const GAS v4u*)(cur + (row - 1) * NSHIFT + col);
        if (!(ch + t > 0)) p = (v4u){0u, 0u, 0u, 0u};
        const f32x4 m0 = *(const GAS f32x4*)(mu + col), m1 = *(const GAS f32x4*)(mu + col + 4);
        float x[8];
        { const float c0 = bflo(c.x), c1 = bfhi(c.x), c2 = bflo(c.y), c3 = bfhi(c.y), c4 = bflo(c.z), c5 = bfhi(c.z), c6 = bflo(c.w), c7 = bfhi(c.w);
          x[0] = c0 + m0.x * (bflo(p.x) - c0); x[1] = c1 + m0.y * (bfhi(p.x) - c1); x[2] = c2 + m0.z * (bflo(p.y) - c2); x[3] = c3 + m0.w * (bfhi(p.y) - c3);
          x[4] = c4 + m1.x * (bflo(p.z) - c4); x[5] = c5 + m1.y * (bfhi(p.z) - c5); x[6] = c6 + m1.z * (bflo(p.w) - c6); x[7] = c7 + m1.w * (bfhi(p.w) - c7); }
        if (vi < 8) {
#pragma unroll
            for (int i = 0; i < 8; ++i) x[i] = ftanh(x[i]);
            *(LAS v4u*)(WD + t * RL + 8 * vi) = (v4u){cvtpk(x[0], x[1]), cvtpk(x[2], x[3]), cvtpk(x[4], x[5]), cvtpk(x[6], x[7])};
        } else if (vi < 16) {
            *(LAS v4u*)(AD + t * RL + 8 * (vi - 8)) = (v4u){cvtpk(x[0], x[1]), cvtpk(x[2], x[3]), cvtpk(x[4], x[5]), cvtpk(x[6], x[7])};
        } else {
#pragma unroll
            for (int i = 0; i < 8; ++i) x[i] = fsig(x[i]);
            *(LAS v4u*)(GD + t * 136 + 8 * (vi - 16)) = (v4u){cvtpk(x[0], x[1]), cvtpk(x[2], x[3]), cvtpk(x[4], x[5]), cvtpk(x[6], x[7])};
        }
    }
    RW_BAR();
    APre PN;
    rwkvA_loadrkv(PN, cur, mu, row0 + p0 + (lane0 & 15), row0 + p0, (ch + p0) > 0, 0, q0, lane0 >> 4);
    HC CN; { int l_ = lane0; asm volatile("" : "+v"(l_)); rwkvA_loadhc<3>(CN, F, mu, W2T, A2T, G2T, 0, q0, l_); }
#pragma unroll 1
    for (int h = 0; h < 8; ++h) {
        int lane = lane0; asm volatile("" : "+v"(lane));
        const int li = lane & 15, lq = lane >> 4;
        const size_t uidx = (size_t)((b * 8 + h) * 32 + ch);
        const HC C = CN;
        f32x4 vr[2], ag[2], gC[2], rtv[2], bhv[2], khv[2];
        {
        f32x4 rr[2], kr[2];
        {
            const APre PC = PN;
            rwkvA_loadrkv(PN, cur, mu, row0 + p0 + li, row0 + p0, (ch + p0) > 0, h < 7 ? h + 1 : 7, q0, lq);
#pragma unroll
            for (int tl = 0; tl < 2; ++tl)
#pragma unroll
                for (int s = 0; s < 3; ++s) {
                    const v2u c = PC.c[tl][s]; v2u p;
                    p.x = (unsigned)__builtin_amdgcn_update_dpp(0, (int)c.x, 0x111, 0xf, 0xf, true); p.y = (unsigned)__builtin_amdgcn_update_dpp(0, (int)c.y, 0x111, 0xf, 0xf, true);
                    if (li == 0) p = PC.p[tl][s];
                    const f32x4 m = C.mu[tl][s];
                    const float c0 = bflo(c.x), c1 = bfhi(c.x), c2 = bflo(c.y), c3 = bfhi(c.y);
                    const f32x4 x = (f32x4){c0 + m.x * (bflo(p.x) - c0), c1 + m.y * (bfhi(p.x) - c1), c2 + m.z * (bflo(p.y) - c2), c3 + m.w * (bfhi(p.y) - c3)};
                    if (s == 0) rr[tl] = x; else if (s == 1) kr[tl] = x; else vr[tl] = x;
                }
        }
        f32x4 aw[2] = {C.w0[0], C.w0[1]}, aa[2] = {C.a0[0], C.a0[1]};
        ag[0] = (f32x4){0.f, 0.f, 0.f, 0.f}; ag[1] = ag[0]; asm volatile("" : "+v"(ag[0]), "+v"(ag[1]));
#pragma unroll
        for (int ks = 0; ks < 2; ++ks) {
            const bf16x8 pw = ldfrag(WD, p0, 32 * ks, lane), pa = ldfrag(AD, p0, 32 * ks, lane);
#pragma unroll
            for (int tl = 0; tl < 2; ++tl) { aw[tl] = mfma_safe(C.qw[ks][tl], pw, aw[tl], 0, 0, 0); aa[tl] = mfma_safe(C.qa[ks][tl], pa, aa[tl], 0, 0, 0); }
        }
#pragma unroll
        for (int ks = 0; ks < 4; ++ks) {
            const bf16x8 pg = *(const LAS bf16x8*)(GD + (p0 + li) * 136 + 32 * ks + 8 * lq);
#pragma unroll
            for (int tl = 0; tl < 2; ++tl) ag[tl] = mfma_safe(C.qg[ks][tl], pg, ag[tl], 0, 0, 0);
        }
#pragma unroll
        for (int tl = 0; tl < 2; ++tl) *(GAS v2u*)(O + (row0 + p0 + li) * OZP + 64 * h + q0 + 16 * tl + 4 * lq) = (v2u){cvtpk(ag[tl][0], ag[tl][1]), cvtpk(ag[tl][2], ag[tl][3])};
        f32x4 ldv[2], alv[2], kkv[2], kpv[2], Lc[2];
        float ss = 0.f, bon = 0.f;
#pragma unroll
        for (int tl = 0; tl < 2; ++tl) {
            const int jc = 64 * h + q0 + 16 * tl + 4 * lq;
            const f32x4 c_kk = C.ckk[tl], c_ka = C.cka[tl], c_rk = C.crk[tl];
#pragma unroll
            for (int r = 0; r < 4; ++r) {
                ldv[tl][r] = -0.6065306597126334f * fsig(aw[tl][r]);
                alv[tl][r] = fsig(aa[tl][r]);
                kkv[tl][r] = kr[tl][r] * c_kk[r]; ss += kkv[tl][r] * kkv[tl][r];
                kpv[tl][r] = kr[tl][r] * (1.0f + (alv[tl][r] - 1.0f) * c_ka[r]);
                bon += rr[tl][r] * kpv[tl][r] * c_rk[r];
                float x = ldv[tl][r];
                x += __builtin_bit_cast(float, __builtin_amdgcn_update_dpp(0, __builtin_bit_cast(int, x), 0x111, 0xf, 0xf, true));
                x += __builtin_bit_cast(float, __builtin_amdgcn_update_dpp(0, __builtin_bit_cast(int, x), 0x112, 0xf, 0xf, true));
                x += __builtin_bit_cast(float, __builtin_amdgcn_update_dpp(0, __builtin_bit_cast(int, x), 0x114, 0xf, 0xf, true));
                x += __builtin_bit_cast(float, __builtin_amdgcn_update_dpp(0, __builtin_bit_cast(int, x), 0x118, 0xf, 0xf, true));
                Lc[tl][r] = x;
            }
        }
        ss = rows_sum(ss); bon = rows_sum(bon);
        if (lane < 16) { XCH[(w * 16 + li) * 2] = ss; XCH[(w * 16 + li) * 2 + 1] = bon; }
        if (li == 15) {
#pragma unroll
            for (int tl = 0; tl < 2; ++tl) *(LAS f32x4*)(LT + (w >> 1) * 64 + q0 + 16 * tl + 4 * lq) = Lc[tl];
        }
        RW_BAR();
        { const int wp = w ^ 1; ss += XCH[(wp * 16 + li) * 2]; bon += XCH[(wp * 16 + li) * 2 + 1]; }
        if ((w & 1) == 0 && lane < 16) BONB[uidx * 64 + p0 + li] = bon;
        const float inv = __builtin_amdgcn_rcpf(fmaxf(__builtin_amdgcn_sqrtf(ss), 1e-12f));
#pragma unroll
        for (int tl = 0; tl < 2; ++tl) {
            const int jq = q0 + 16 * tl + 4 * lq;
            f32x4 off = {0.f, 0.f, 0.f, 0.f}, tot = {0.f, 0.f, 0.f, 0.f};
#pragma unroll
            for (int pb = 0; pb < 4; ++pb) { const f32x4 x = *(const LAS f32x4*)(LT + pb * 64 + jq); tot += x; if (pb < (w >> 1)) off += x; }
            f32x4 at, bb, kb;
#pragma unroll
            for (int r = 0; r < 4; ++r) {
                const float Lt = Lc[tl][r] + off[r], gt = __expf(Lt), gp = __expf(Lt - ldv[tl][r]), gi = __expf(-Lt);
                gC[tl][r] = __expf(tot[r]);
                const float gh = gC[tl][r] * gi;
                const float kn = kkv[tl][r] * inv, bv = kn * alv[tl][r];
                at[r] = -kn * gp; rtv[tl][r] = rr[tl][r] * gt; bb[r] = bv * gi; kb[r] = kpv[tl][r] * gi; bhv[tl][r] = bv * gh; khv[tl][r] = kpv[tl][r] * gh;
            }
            const int ro = (p0 + li) * RL + jq;
            *(LAS v2u*)(ASL(A_AT) + ro) = (v2u){cvtpk(at[0], at[1]), cvtpk(at[2], at[3])};
            *(LAS v2u*)(ASL(A_RT) + ro) = (v2u){cvtpk(rtv[tl][0], rtv[tl][1]), cvtpk(rtv[tl][2], rtv[tl][3])};
            *(LAS v2u*)(ASL(A_BB) + ro) = (v2u){cvtpk(bb[0], bb[1]), cvtpk(bb[2], bb[3])};
            *(LAS v2u*)(ASL(A_KB) + ro) = (v2u){cvtpk(kb[0], kb[1]), cvtpk(kb[2], kb[3])};
            { const unsigned a0 = cvtpk(at[0], at[1]), a1 = cvtpk(at[2], at[3]), v0 = cvtpk(vr[tl][0], vr[tl][1]), v1 = cvtpk(vr[tl][2], vr[tl][3]);
              const int co = jq * RL + p0 + li;
              LAS bf16* pa = ASL(A_ATT) + co; LAS bf16* pv = ASL(A_VT) + co;
              pa[0] = (bf16)(a0 & 0xffffu); pa[RL] = (bf16)(a0 >> 16); pa[2 * RL] = (bf16)(a1 & 0xffffu); pa[3 * RL] = (bf16)(a1 >> 16);
              pv[0] = (bf16)(v0 & 0xffffu); pv[RL] = (bf16)(v0 >> 16); pv[2 * RL] = (bf16)(v1 & 0xffffu); pv[3 * RL] = (bf16)(v1 >> 16); }
        }
        RW_BAR();
        }
        f32x4 ndiag = {0.f, 0.f, 0.f, 0.f};
        {
            f32x4 n_[2] = ZERO2, mak[2] = ZERO2, mrb[2] = ZERO2, mrk[2] = ZERO2; asm volatile("" : "+v"(n_[0]), "+v"(n_[1]), "+v"(mak[0]), "+v"(mak[1]), "+v"(mrb[0]), "+v"(mrb[1]), "+v"(mrk[0]), "+v"(mrk[1]));
            mm2<2>(n_, ASL(A_AT), ASL(A_BB), p0, q0, lane); mm2<2>(mak, ASL(A_AT), ASL(A_KB), p0, q0, lane);
            mm2<2>(mrb, ASL(A_RT), ASL(A_BB), p0, q0, lane); mm2<2>(mrk, ASL(A_RT), ASL(A_KB), p0, q0, lane);
#pragma unroll
            for (int tl = 0; tl < 2; ++tl) {
#pragma unroll
                for (int r = 0; r < 4; ++r) { const int t = p0 + li, s_ = q0 + 16 * tl + 4 * lq + r;
                    if (!(t > s_)) { n_[tl][r] = 0.f; mak[tl][r] = 0.f; } if (!(t >= s_)) { mrb[tl][r] = 0.f; mrk[tl][r] = 0.f; } }
                if (q0 + 16 * tl == p0) ndiag = n_[tl];
            }
            st_pq_h(ASL(A_N), n_, p0, q0, lane); st_pq_h(ASL(A_MAK), mak, p0, q0, lane); st_pq_h(ASL(A_MRB), mrb, p0, q0, lane); st_pq_h(ASL(A_MRK), mrk, p0, q0, lane);
        }
        RW_BAR();
        rwkvA_loadhc<2>(CN, F, mu, W2T, A2T, G2T, h < 7 ? h + 1 : 7, q0, lane);
        {
            f32x4 rh[2] = ZERO2; asm volatile("" : "+v"(rh[0]), "+v"(rh[1]));
            mm2<2>(rh, ASL(A_VT), ASL(A_MAK), p0, q0, lane);
            st_pq_h(ASL(A_RHS), rh, p0, q0, lane);
            st_qp_h(ASL(A_BHT), bhv, p0, q0, lane); st_qp_h(ASL(A_KHT), khv, p0, q0, lane);
            if (q0 == (p0 & 32)) {
                LAS bf16* SP = ASL(A_ND) + (p0 >> 4) * (3 * 16 * DL); LAS bf16* SPT = SP + 16 * DL; LAS bf16* ST = SPT + 16 * DL;
                f32x4 Tb = ndiag, Pb = ndiag;
#pragma unroll
                for (int r = 0; r < 4; ++r) if (li == 4 * lq + r) Tb[r] += 1.0f;
#pragma unroll
                for (int lev = 0; lev < 4; ++lev) {
                    st16_pq(SP, Pb, lane); st16_qp(SPT, Pb, lane); st16_pq(ST, Tb, lane);
                    LDS_WAIT();
                    const bf16x8 fp = ld16(SP, lane), fpt = ld16(SPT, lane), ft = ld16(ST, lane);
                    if (lev > 0) Tb = mfma_safe(fpt, ft, Tb, 0, 0, 0);
                    if (lev < 3) { f32x4 z = {0.f, 0.f, 0.f, 0.f}; asm volatile("" : "+v"(z)); Pb = mfma_safe(fpt, fp, z, 0, 0, 0); }
                    LDS_WAIT();
                }
                st16_pq(ASL(A_TR) + (p0 >> 4) * (16 * DL), Tb, lane);
            }
        }
        RW_BAR();
        rwkvA_loadhc<1>(CN, F, mu, W2T, A2T, G2T, h < 7 ? h + 1 : 7, q0, lane);
        {
            const int ct = w & 3;
            const LAS bf16* src = (w < 4 ? ASL(A_ATT) : ASL(A_RHS)) + (16 * ct + li) * RL + 4 * lq;
            LAS bf16* XT = (w < 4 ? ASL(A_WT) : ASL(A_ULT)) + (16 * ct + li) * RL + 4 * lq;
            const LAS bf16* Nr = ASL(A_N) + li * RL + 4 * lq;
            const LAS bf16* Dr = ASL(A_TR) + li * DL + 4 * lq;
            v2u rh_[4], d_[4];
#pragma unroll
            for (int bb = 0; bb < 4; ++bb) { rh_[bb] = *(const LAS v2u*)(src + 16 * bb); d_[bb] = *(const LAS v2u*)(Dr + bb * (16 * DL)); }
            const v2u n10 = *(const LAS v2u*)(Nr + 16 * RL), n20 = *(const LAS v2u*)(Nr + 32 * RL), n21 = *(const LAS v2u*)(Nr + 32 * RL + 16);
            const v2u n30 = *(const LAS v2u*)(Nr + 48 * RL), n31 = *(const LAS v2u*)(Nr + 48 * RL + 16), n32 = *(const LAS v2u*)(Nr + 48 * RL + 32);
            LDS_WAIT();
#define SUB_FR(lo, hi) __builtin_bit_cast(bf16x8, ((v4u){(lo).x, (lo).y, (hi).x, (hi).y}))
#define SUB_PK(a)      ((v2u){cvtpk((a)[0], (a)[1]), cvtpk((a)[2], (a)[3])})
#define SUB_UNP(u)     ((f32x4){bflo((u).x), bfhi((u).x), bflo((u).y), bfhi((u).y)})
            const v2u z2 = {0u, 0u};
            f32x4 x[4];
#pragma unroll
            for (int bb = 0; bb < 4; ++bb) {
                f32x4 y = SUB_UNP(rh_[bb]);
                if (bb == 1) y = mfma_safe(SUB_FR(n10, z2), SUB_FR(SUB_PK(x[0]), z2), y, 0, 0, 0);
                if (bb == 2) y = mfma_safe(SUB_FR(n20, n21), SUB_FR(SUB_PK(x[0]), SUB_PK(x[1])), y, 0, 0, 0);
                if (bb == 3) { y = mfma_safe(SUB_FR(n30, n31), SUB_FR(SUB_PK(x[0]), SUB_PK(x[1])), y, 0, 0, 0); y = mfma_safe(SUB_FR(n32, z2), SUB_FR(SUB_PK(x[2]), z2), y, 0, 0, 0); }
                f32x4 z = {0.f, 0.f, 0.f, 0.f}; asm volatile("" : "+v"(z));
                x[bb] = mfma_safe(SUB_FR(d_[bb], z2), SUB_FR(SUB_PK(y), z2), z, 0, 0, 0);
                *(LAS v2u*)(XT + 16 * bb) = SUB_PK(x[bb]);
            }
#undef SUB_FR
#undef SUB_PK
#undef SUB_UNP
        }
        RW_BAR();
        {
            bf16* base = RQ + uidx * 16384;
            f32x4 qv[2] = {rtv[0], rtv[1]}, yl[2] = ZERO2, gt[2] = ZERO2, hv[2] = ZERO2; asm volatile("" : "+v"(yl[0]), "+v"(yl[1]), "+v"(gt[0]), "+v"(gt[1]), "+v"(hv[0]), "+v"(hv[1]));
            mm2<2>(qv, ASL(A_MRB), ASL(A_WT), p0, q0, lane);
            mm2<2>(yl, ASL(A_MRB), ASL(A_ULT), p0, q0, lane); mm2<2>(yl, ASL(A_MRK), ASL(A_VT), p0, q0, lane);
            mm2<2>(gt, ASL(A_BHT), ASL(A_WT), p0, q0, lane);
            mm2<2>(hv, ASL(A_ULT), ASL(A_BHT), p0, q0, lane); mm2<2>(hv, ASL(A_VT), ASL(A_KHT), p0, q0, lane);
#pragma unroll
            for (int tl = 0; tl < 2; ++tl)
#pragma unroll
                for (int r = 0; r < 4; ++r) if (p0 + li == q0 + 16 * tl + 4 * lq + r) gt[tl][r] += gC[tl][r];
            st_glob(base, qv, p0, q0, lane); st_glob(base + 4096, yl, p0, q0, lane); st_glob(base + 8192, gt, p0, q0, lane); st_glob(base + 12288, hv, p0, q0, lane);
        }
        RW_BAR();
    }
}

constexpr int B_BUF = 2 * RSLOT, B_XOFF = B_BUF + 2 * 32768;
struct BPre { v4u raw[4]; v2u g2[2], cc[2], cp[2]; float bon; };
template <int PART>
__device__ __forceinline__ void rwkvB_load(BPre& P, const bf16* RQ, const float* BONB, const bf16* cur, const bf16* O, int b, int h, int ch, int p0, int q0, int lane, int w) {
    const int li = lane & 15, lq = lane >> 4;
    const size_t uidx = (size_t)((b * 8 + h) * 32 + ch), row = (size_t)b * SEQ + ch * 64 + p0 + li;
    if (PART & 1) {
        const unsigned char* blk = (const unsigned char*)(RQ + uidx * 16384) + w * 4096 + lane * 16;
#pragma unroll
        for (int i = 0; i < 4; ++i) P.raw[i] = *(const GAS v4u*)(blk + i * 1024);
    }
    if (PART & 2) {
        const bool hasprev = (ch + p0) > 0;
#pragma unroll
        for (int tl = 0; tl < 2; ++tl) {
            const int col = 1024 + 64 * h + q0 + 16 * tl + 4 * lq;
            P.g2[tl] = *(const GAS v2u*)(O + row * OZP + 64 * h + q0 + 16 * tl + 4 * lq);
            P.cc[tl] = *(const GAS v2u*)(cur + row * NSHIFT + col);
            { const v2u pv = *(const GAS v2u*)(cur + (row - li - 1) * NSHIFT + col);
              P.cp[tl] = hasprev ? pv : (v2u){0u, 0u}; }
        }
        P.bon = BONB[uidx * 64 + p0 + li];
    }
}
__device__ __forceinline__ bf16x8 ldfrag_sw(const LAS bf16* Mx, int row0, int k0, int lane) { const int r = row0 + (lane & 15), c = (k0 >> 3) + (lane >> 4); return *(const LAS bf16x8*)(Mx + r * 64 + ((c ^ (r & 7)) << 3)); }
__device__ __forceinline__ void rwkvB_step(Frame& F, const BPre& Pn, const BPre& Pc, f32x4 (&Sreg)[2], const f32x4 (&mu4)[2], const f32x4 (&lnw)[2], const f32x4 (&lnb)[2], bf16* O, size_t rowmask, int b, int h, int ch, int p0, int q0, int lane, int w) {
    const int li = lane & 15, lq = lane >> 4, pp = ch & 1;
    LAS float* XCH2 = (LAS float*)(F.lds + B_XOFF);
    const LAS bf16* Sb = ASL(pp); LAS bf16* Sn = ASL(pp ^ 1);
    const LAS bf16* Bc = (const LAS bf16*)(F.lds + B_BUF + pp * 32768);
    {   LAS unsigned char* Bn = F.lds + B_BUF + (pp ^ 1) * 32768 + w * 4096 + lane * 16;
#pragma unroll
        for (int i = 0; i < 4; ++i) *(LAS v4u*)(Bn + i * 1024) = Pn.raw[i]; }
    f32x4 Yreg[2], Sacc[2];
#pragma unroll
    for (int tl = 0; tl < 2; ++tl) { const int o = swz_off(p0 + li, q0 + 16 * tl + 4 * lq);
        const v2u yl = *(const LAS v2u*)(Bc + 4096 + o), hh = *(const LAS v2u*)(Bc + 12288 + o);
        Yreg[tl] = (f32x4){bflo(yl.x), bfhi(yl.x), bflo(yl.y), bfhi(yl.y)}; Sacc[tl] = (f32x4){bflo(hh.x), bfhi(hh.x), bflo(hh.y), bfhi(hh.y)}; }
#pragma unroll
    for (int ks = 0; ks < 2; ++ks) {
        const bf16x8 sp = ldfrag(Sb, p0, 32 * ks, lane);
        const bf16x8 qf = ldfrag_sw(Bc, p0, 32 * ks, lane);
#pragma unroll
        for (int tl = 0; tl < 2; ++tl) {
            const bf16x8 sq = ldfrag(Sb, q0 + 16 * tl, 32 * ks, lane);
            const bf16x8 gq = ldfrag_sw(Bc + 8192, q0 + 16 * tl, 32 * ks, lane);
            Yreg[tl] = mfma_safe(sq, qf, Yreg[tl], 0, 0, 0);
            Sacc[tl] = mfma_safe(gq, sp, Sacc[tl], 0, 0, 0);
        }
    }
    st_pq_h(Sn, Sacc, p0, q0, lane);
    Sreg[0] = Sacc[0]; Sreg[1] = Sacc[1];
    float s = 0.f;
#pragma unroll
    for (int tl = 0; tl < 2; ++tl) s += (Yreg[tl][0] + Yreg[tl][1]) + (Yreg[tl][2] + Yreg[tl][3]);
    s = rows_sum(s);
    const float mw = s * (1.0f / 32.0f); float q = 0.f;
#pragma unroll
    for (int tl = 0; tl < 2; ++tl)
#pragma unroll
        for (int r = 0; r < 4; ++r) { const float d = Yreg[tl][r] - mw; q += d * d; }
    q = rows_sum(q);
    LAS float* X2 = XCH2 + pp * 256;
    if (lane < 16) { X2[(w * 16 + li) * 2] = mw; X2[(w * 16 + li) * 2 + 1] = q; }
    RW_BAR();
    const float mo = X2[((w ^ 1) * 16 + li) * 2], qo = X2[((w ^ 1) * 16 + li) * 2 + 1];
    const float mean = 0.5f * (mw + mo), dm = mw - mo, m2 = q + qo + 16.0f * dm * dm;
    const float rstd = __builtin_amdgcn_rsqf(m2 * (1.0f / 64.0f) + GN_EPS);
    const size_t row = (size_t)b * SEQ + ch * 64 + p0 + li;
#pragma unroll
    for (int tl = 0; tl < 2; ++tl) {
        const float c0 = bflo(Pc.cc[tl].x), c1 = bfhi(Pc.cc[tl].x), c2 = bflo(Pc.cc[tl].y), c3 = bfhi(Pc.cc[tl].y);
        v2u cpv;
        cpv.x = (unsigned)__builtin_amdgcn_update_dpp(0, (int)Pc.cc[tl].x, 0x111, 0xf, 0xf, true); cpv.y = (unsigned)__builtin_amdgcn_update_dpp(0, (int)Pc.cc[tl].y, 0x111, 0xf, 0xf, true);
        if (li == 0) cpv = Pc.cp[tl];
        const f32x4 vr = (f32x4){c0 + mu4[tl].x * (bflo(cpv.x) - c0), c1 + mu4[tl].y * (bfhi(cpv.x) - c1), c2 + mu4[tl].z * (bflo(cpv.y) - c2), c3 + mu4[tl].w * (bfhi(cpv.y) - c3)};
        const f32x4 gg = (f32x4){bflo(Pc.g2[tl].x), bfhi(Pc.g2[tl].x), bflo(Pc.g2[tl].y), bfhi(Pc.g2[tl].y)};
        float o[4];
#pragma unroll
        for (int r = 0; r < 4; ++r) o[r] = ((Yreg[tl][r] - mean) * rstd * lnw[tl][r] + lnb[tl][r] + Pc.bon * vr[r]) * gg[r];
        *(GAS v2u*)(O + (row & rowmask) * OZP + 64 * h + q0 + 16 * tl + 4 * lq) = (v2u){cvtpk(o[0], o[1]), cvtpk(o[2], o[3])};
    }
}
__device__ __forceinline__ void rwkvB_unit(Frame& F, int b, int h, bf16* Oout, size_t rowmask) {
    const int w = F.wave, lane0 = F.lane;
    const int p0 = 16 * (w >> 1), q0 = 32 * (w & 1);
    const bf16* cur = (const bf16*)(F.a->ws + WS_CUR); const bf16* O = (const bf16*)(F.a->ws + WS_O);
    const bf16* RQ = (const bf16*)(F.a->ws + WS_RQ); const float* BONB = (const float*)(F.a->ws + WS_BON);
    f32x4 Sreg[2] = ZERO2;
    st_pq_h(ASL(0), Sreg, p0, q0, lane0);
    f32x4 mu4[2], lnw[2], lnb[2];
#pragma unroll
    for (int tl = 0; tl < 2; ++tl) { const int jc = 64 * h + q0 + 16 * tl + 4 * (lane0 >> 4);
        mu4[tl] = *(const GAS f32x4*)(F.a->in[I_MU] + 1024 + jc); lnw[tl] = *(const GAS f32x4*)(F.a->in[I_LNW] + jc); lnb[tl] = *(const GAS f32x4*)(F.a->in[I_LNB] + jc); }
    constexpr int NCH = SEQ / 64;
    static_assert(NCH % 4 == 0, "phase B loop shape");
#define BLOAD(PART_, P_, c_) rwkvB_load<PART_>(P_, RQ, BONB, cur, O, b, h, (c_) < NCH ? (c_) : NCH - 1, p0, q0, lane, w)
#define BSTEP(Pn_, Pc_, c_) rwkvB_step(F, Pn_, Pc_, Sreg, mu4, lnw, lnb, Oout, rowmask, b, h, (c_), p0, q0, lane, w)
    BPre P0, P1, P2, P3;
    {   int lane = lane0;
        BLOAD(3, P0, 0); BLOAD(3, P1, 1); BLOAD(3, P2, 2); BLOAD(1, P3, 3);
        LAS unsigned char* B0 = F.lds + B_BUF + w * 4096 + lane * 16;
#pragma unroll
        for (int i = 0; i < 4; ++i) *(LAS v4u*)(B0 + i * 1024) = P0.raw[i];
    }
    RW_BAR();
#pragma unroll 1
    for (int ch = 0; ch < NCH; ch += 4) {
        int lane = lane0; asm volatile("" : "+v"(lane));
        BLOAD(2, P3, ch + 3); BLOAD(1, P0, ch + 4); BSTEP(P1, P0, ch);
        BLOAD(2, P0, ch + 4); BLOAD(1, P1, ch + 5); BSTEP(P2, P1, ch + 1);
        BLOAD(2, P1, ch + 5); BLOAD(1, P2, ch + 6); BSTEP(P3, P2, ch + 2);
        BLOAD(2, P2, ch + 6); BLOAD(1, P3, ch + 7); BSTEP(P0, P3, ch + 3);
    }
#undef BLOAD
#undef BSTEP
    {
        const int li = lane0 & 15, lq = lane0 >> 4;
        float* so = F.a->out + O_WKV_P + ((size_t)(b * 8 + h) * 64 + p0 + li) * 64 + q0 + 4 * lq;
#pragma unroll
        for (int tl = 0; tl < 2; ++tl) *(GAS f32x4*)(so + 16 * tl) = Sreg[tl];
    }
}

__device__ __forceinline__ void sample_mix_unit(Frame& F, int unit) {
    const int lane = F.lane, w = F.wave, li = lane & 15, lq = lane >> 4;
    const int T = 2 * unit + (w >> 2), strip = T & 63, rb = T >> 6, kq = w & 3;
    const bf16* OZ = (const bf16*)(F.a->ws + WS_OZ); const bf16* GPT = (const bf16*)(F.a->ws + WS_GPT);
    const bf16* gates = (const bf16*)(F.a->ws + WS_GATES); bf16* MMp = (bf16*)(F.a->ws + WS_S5IN);
    const size_t arow = (size_t)(MP + 16 * rb + li) * OZP + 8 * lq + 128 * kq;
    const int c = 16 * strip + li;
    const size_t vrow = (size_t)(256 * (c >> 7) + (c & 127)) * 1024 + 8 * lq + 128 * kq, grow = vrow + 128 * 1024, prow = (size_t)c * 1024 + 512 + 8 * lq + 128 * kq;
    const size_t row = (size_t)MP + 16 * rb + li; const int col = 16 * strip + 4 * lq;
    bf16x8 az[4], ao[4], bv[4], bg[4], bp[4];
#pragma unroll
    for (int i = 0; i < 4; ++i) { az[i] = *(const GAS bf16x8*)(OZ + arow + 32 * i); ao[i] = *(const GAS bf16x8*)(OZ + arow + 512 + 32 * i);
        bv[i] = *(const GAS bf16x8*)(GPT + vrow + 32 * i); bg[i] = *(const GAS bf16x8*)(GPT + grow + 32 * i); bp[i] = *(const GAS bf16x8*)(GPT + prow + 32 * i); }
    const v2u g1 = *(const GAS v2u*)(gates + row * 2048 + col), g2 = *(const GAS v2u*)(gates + row * 2048 + 1024 + col);
    f32x4 av = {0.f, 0.f, 0.f, 0.f}, ag = av, ar = av; asm volatile("" : "+v"(av), "+v"(ag), "+v"(ar));
#pragma unroll
    for (int i = 0; i < 4; ++i) { av = mfma_safe(bv[i], az[i], av, 0, 0, 0); ag = mfma_safe(bg[i], az[i], ag, 0, 0, 0); ar = mfma_safe(bp[i], ao[i], ar, 0, 0, 0); }
    LAS f32x4* X = (LAS f32x4*)F.lds + (w * 3) * 64 + lane;
    asm volatile("s_nop 15\n\ts_nop 15" : "+v"(av), "+v"(ag), "+v"(ar));
    if (kq) { X[0] = av; X[64] = ag; X[128] = ar; }
    RW_BAR();
    if (kq == 0) {
#pragma unroll
        for (int q = 1; q < 4; ++q) { av += X[(q * 3) * 64]; ag += X[(q * 3 + 1) * 64]; ar += X[(q * 3 + 2) * 64]; }
        const float m0 = bflo(g1.x) * (av[0] * fsig(ag[0])) + bflo(g2.x) * ar[0], m1 = bfhi(g1.x) * (av[1] * fsig(ag[1])) + bfhi(g2.x) * ar[1];
        const float m2 = bflo(g1.y) * (av[2] * fsig(ag[2])) + bflo(g2.y) * ar[2], m3 = bfhi(g1.y) * (av[3] * fsig(ag[3])) + bfhi(g2.y) * ar[3];
        *(GAS v2u*)(MMp + row * 1024 + col) = (v2u){cvtpk(m0, m1), cvtpk(m2, m3)};
    }
    RW_BAR();
}

template <int K>
__device__ __forceinline__ void dec_proj_part1(Frame& F, int unit, const bf16* A, int lda, const bf16* Bt, bf16* hb, int gidx, float scale, float* rowss, unsigned* flag, float* obuf, bool fin) {
    const int lane = F.lane, w = F.wave, li = lane & 15, lq = lane >> 4;
    const int T = 2 * unit + (w >> 2), strip = T & 63, rb = T >> 6, kq = w & 3;
    constexpr int KQ = K / 4, NKS = KQ / 32, NBT = (NKS > 11 ? 11 : NKS);
    static_assert(NKS % NBT == 0, "decode projection: batch shape");
    const bf16* ap = A + (size_t)(MP + 16 * rb + li) * lda + kq * KQ + 8 * lq;
    const bf16* bp = Bt + (size_t)(16 * strip + li) * K + kq * KQ + 8 * lq;
    const int row = 16 * rb + li, col = 16 * strip + 4 * lq;
    const float* mrow = (const float*)(F.a->ws + WS_MOD) + (size_t)(8 + row) * NMOD;
    bf16* hp = hb + (size_t)(MP + row) * HP + col;
    const f32x4 gv = *(const GAS f32x4*)(mrow + gidx * D + col); const v2u hv = *(const GAS v2u*)hp;
    f32x4 acc = {0.f, 0.f, 0.f, 0.f}; asm volatile("" : "+v"(acc));
#pragma unroll 1
    for (int bt = 0; bt < NKS / NBT; ++bt) {
        bf16x8 a_[NBT], b_[NBT];
#pragma unroll
        for (int i = 0; i < NBT; ++i) { a_[i] = *(const GAS bf16x8*)(ap + 32 * (bt * NBT + i)); b_[i] = *(const GAS bf16x8*)(bp + 32 * (bt * NBT + i)); }
#pragma unroll
        for (int i = 0; i < NBT; ++i) acc = mfma_safe(b_[i], a_[i], acc, 0, 0, 0);
    }
    LAS f32x4* X = (LAS f32x4*)F.lds + w * 64 + lane;
    asm volatile("s_nop 15\n\ts_nop 15" : "+v"(acc));
    if (kq) X[0] = acc;
    RW_BAR();
    if (kq == 0) {
        acc += X[64]; acc += X[128]; acc += X[192];
        const f32x4 o = (f32x4){bflo(hv.x), bfhi(hv.x), bflo(hv.y), bfhi(hv.y)} + (gv * scale) * acc;
        if (!fin) *(GAS v2u*)hp = (v2u){cvtpk(o[0], o[1]), cvtpk(o[2], o[3])};
        *(GAS f32x4*)(obuf + (size_t)row * D + col) = o;
        const float q = rows_sum((o[0] * o[0] + o[1] * o[1]) + (o[2] * o[2] + o[3] * o[3]));
        if (lq == 0) { float* p = rowss + (size_t)row * 64 + strip; asm volatile("global_store_dword %0, %1, off sc1" :: "v"(p), "v"(q) : "memory"); }
    }
    asm volatile("s_waitcnt vmcnt(0)" ::: "memory");
    RW_BAR();
    if (F.tid == 0) (void)__hip_atomic_fetch_add(flag + rb * 16, 2u, __ATOMIC_RELAXED, __HIP_MEMORY_SCOPE_AGENT);
}
typedef int dv8i __attribute__((ext_vector_type(8)));
__device__ __forceinline__ void dec_proj_part1_f8(Frame& F, int unit, const unsigned char* A, const unsigned char* Bt, bf16* hb, int gidx, float scale, float* rowss, unsigned* flag, float* obuf, bool fin) {
    const int lane = F.lane, w = F.wave, li = lane & 15, lq = lane >> 4;
    const int T = 2 * unit + (w >> 2), strip = T & 63, rb = T >> 6, kq = w & 3;
    const int c0 = kq < 2 ? 6 * kq : 12 + 5 * (kq - 2), nc = kq < 2 ? 6 : 5;
    const unsigned char* ap = A + (size_t)(MP + 16 * rb + li) * DFF + 128 * c0 + 32 * lq;
    const unsigned char* bp = Bt + (size_t)(16 * strip + li) * DFF + 128 * c0 + 32 * lq;
    const int row = 16 * rb + li, col = 16 * strip + 4 * lq;
    const float* mrow = (const float*)(F.a->ws + WS_MOD) + (size_t)(8 + row) * NMOD;
    bf16* hp = hb + (size_t)(MP + row) * HP + col;
    const f32x4 gv = *(const GAS f32x4*)(mrow + gidx * D + col); const v2u hv = *(const GAS v2u*)hp;
    f32x4 acc = {0.f, 0.f, 0.f, 0.f}; asm volatile("" : "+v"(acc));
    {
        dv8i a_[6], b_[6];
#pragma unroll
        for (int i = 0; i < 6; ++i) { const int ii = i < nc ? i : nc - 1;
            a_[i] = *(const GAS dv8i*)(ap + 128 * ii); b_[i] = *(const GAS dv8i*)(bp + 128 * ii); }
#pragma unroll
        for (int i = 0; i < 6; ++i) { f32x4 t = __builtin_amdgcn_mfma_scale_f32_16x16x128_f8f6f4(b_[i], a_[i], acc, 0, 0, 0, 0x7f7f7f7f, 0, 0x7f7f7f7f);
            asm volatile("" :: "v"(t), "v"(a_[i]), "v"(b_[i]));
            acc = (i < nc) ? t : acc; }
    }
    LAS f32x4* X = (LAS f32x4*)F.lds + w * 64 + lane;
    asm volatile("s_nop 15\n\ts_nop 15" : "+v"(acc));
    if (kq) X[0] = acc;
    RW_BAR();
    if (kq == 0) {
        acc += X[64]; acc += X[128]; acc += X[192];
        const f32x4 o = (f32x4){bflo(hv.x), bfhi(hv.x), bflo(hv.y), bfhi(hv.y)} + (gv * scale) * acc;
        if (!fin) *(GAS v2u*)hp = (v2u){cvtpk(o[0], o[1]), cvtpk(o[2], o[3])};
        *(GAS f32x4*)(obuf + (size_t)row * D + col) = o;
        const float q = rows_sum((o[0] * o[0] + o[1] * o[1]) + (o[2] * o[2] + o[3] * o[3]));
        if (lq == 0) { float* p = rowss + (size_t)row * 64 + strip; asm volatile("global_store_dword %0, %1, off sc1" :: "v"(p), "v"(q) : "memory"); }
    }
    asm volatile("s_waitcnt vmcnt(0)" ::: "memory");
    RW_BAR();
    if (F.tid == 0) (void)__hip_atomic_fetch_add(flag + rb * 16, 2u, __ATOMIC_RELAXED, __HIP_MEMORY_SCOPE_AGENT);
}
__device__ __forceinline__ void dec_proj_part2(Frame& F, int unit, const float* rowss, unsigned* flag, const float* obuf, const float* gn, int sh_idx, int sc_idx, bf16* xn, float* y, bool xn8 = false) {
    int lane = F.lane; asm volatile("" : "+v"(lane));
    const int w = F.wave, li = lane & 15, lq = lane >> 4;
    const int T = 2 * unit + (w >> 2), strip = T & 63, rb = T >> 6, kq = w & 3;
    const int row = 16 * rb + li, col = 16 * strip + 4 * lq;
    const float* mrow = (const float*)(F.a->ws + WS_MOD) + (size_t)(8 + row) * NMOD;
    if (F.tid == 0) { unsigned* f = flag + rb * 16; unsigned sp = 0u; while (__hip_atomic_load(f, __ATOMIC_RELAXED, __HIP_MEMORY_SCOPE_AGENT) < 64u) { __builtin_amdgcn_s_sleep(1); if (++sp > (1u << 18)) break; } }
    asm volatile("s_waitcnt vmcnt(0)" ::: "memory");
    RW_BAR();
    if (kq == 0) {
        const f32x4 o = *(const GAS f32x4*)(obuf + (size_t)row * D + col);
        f32x4 ps[4];
        { const float* p = rowss + (size_t)row * 64 + 16 * lq;
#pragma unroll
          for (int i = 0; i < 4; ++i) { const float* pi = p + 4 * i; asm volatile("global_load_dwordx4 %0, %1, off sc1" : "=v"(ps[i]) : "v"(pi) : "memory"); }
          asm volatile("s_waitcnt vmcnt(0)" : "+v"(ps[0]), "+v"(ps[1]), "+v"(ps[2]), "+v"(ps[3]) :: "memory"); }
        const f32x4 t4 = (ps[0] + ps[1]) + (ps[2] + ps[3]);
        const float tot = rows_sum((t4.x + t4.y) + (t4.z + t4.w));
        const float rstd = 1.0f / sqrtf(tot * (1.0f / D) + NORM_EPS);
        const f32x4 n = o * rstd * *(const GAS f32x4*)(gn + col);
        if (y) *(GAS f32x4*)(y + (size_t)(MP + row) * D + col) = n;
        else { const f32x4 x = n * (*(const GAS f32x4*)(mrow + sc_idx * D + col) + 1.0f) + *(const GAS f32x4*)(mrow + sh_idx * D + col);
            if (xn8) *(GAS unsigned*)((unsigned char*)xn + (size_t)(MP + row) * D + col) = pk4f8(x[0] * pg8::F8_SX, x[1] * pg8::F8_SX, x[2] * pg8::F8_SX, x[3] * pg8::F8_SX);
            else *(GAS v2u*)(xn + (size_t)(MP + row) * D + col) = (v2u){cvtpk(x[0], x[1]), cvtpk(x[2], x[3])}; }
    }
}

struct S5Par { float lbr, lbi; float bbr[16], bbi[16]; };
__device__ __forceinline__ void s5_params(Frame& F, int g, int n, S5Par& P, double& lbr_d, double& lbi_d) {
    const double dt = exp((double)F.a->in[I_LOGDT][g]);
    const double lr = (double)F.a->in[I_LAMRE][g * 64 + n], li = (double)F.a->in[I_LAMIM][g * 64 + n];
    const double mag = exp(lr * dt), ang = li * dt;
    const double lbr = mag * cos(ang), lbi = mag * sin(ang);
    const double den = lr * lr + li * li, numr = lbr - 1.0;
    const double kr = (numr * lr + lbi * li) / den, ki = (lbi * lr - numr * li) / den;
    lbr_d = lbr; lbi_d = lbi; P.lbr = (float)lbr; P.lbi = (float)lbi;
    const float* bre = F.a->in[I_BRE] + (size_t)(g * 64 + n) * 16; const float* bim = F.a->in[I_BIM] + (size_t)(g * 64 + n) * 16;
    const float krf = (float)kr, kif = (float)ki;
#pragma unroll
    for (int c = 0; c < 16; ++c) { const float br = bre[c], bi = bim[c]; P.bbr[c] = krf * br - kif * bi; P.bbi[c] = krf * bi + kif * br; }
}
__device__ __forceinline__ void s5_prompt_unit(Frame& F, int b, int g) {
    LAS float* CRE = (LAS float*)F.lds;
    LAS float* CIM = CRE + 16 * 68;
    LAS float* ERE = CIM + 16 * 68;
    LAS float* EIM = ERE + 8 * 64;
    LAS float* WV = EIM + 8 * 64 + F.wave * (256 + 2 * 16 * 68);
    LAS float* UB = WV;
    LAS float* XRE = WV + 256;
    LAS float* XIM = XRE + 16 * 68;
    const int n = F.lane, w = F.wave;
    const bf16* s5in = (const bf16*)(F.a->ws + WS_S5IN); bf16* Z = (bf16*)(F.a->ws + WS_Z);
    S5Par P; double lbr_d, lbi_d; s5_params(F, g, n, P, lbr_d, lbi_d);
    for (int i = F.tid; i < 1024; i += 512) { const int c = i >> 6, nn = i & 63; CRE[c * 68 + nn] = F.a->in[I_CRE][g * 1024 + i]; CIM[c * 68 + nn] = F.a->in[I_CIM][g * 1024 + i]; }
    const int tok = F.lane >> 2, q = F.lane & 3;
    const size_t rowbase = (size_t)b * SEQ + 256 * w;
    float xr = 0.f, xi = 0.f;
#pragma unroll 1
    for (int blk = 0; blk < 16; ++blk) {
        const v2u raw = *(const GAS v2u*)(s5in + (rowbase + blk * 16 + tok) * 512 + 16 * g + 4 * q);
        *(LAS f32x4*)(UB + tok * 16 + 4 * q) = (f32x4){bflo(raw.x), bfhi(raw.x), bflo(raw.y), bfhi(raw.y)};
        LDS_WAIT();
#pragma unroll 2
        for (int i = 0; i < 16; ++i) {
            float u[16];
#pragma unroll
            for (int k = 0; k < 4; ++k) { const f32x4 t = *(const LAS f32x4*)(UB + i * 16 + 4 * k); u[4 * k] = t.x; u[4 * k + 1] = t.y; u[4 * k + 2] = t.z; u[4 * k + 3] = t.w; }
            float bur = 0.f, bui = 0.f;
#pragma unroll
            for (int c = 0; c < 16; ++c) { bur += P.bbr[c] * u[c]; bui += P.bbi[c] * u[c]; }
            const float nr = P.lbr * xr - P.lbi * xi + bur, ni = P.lbr * xi + P.lbi * xr + bui; xr = nr; xi = ni;
        }
        LDS_WAIT();
    }
    ERE[w * 64 + n] = xr; EIM[w * 64 + n] = xi;
    __syncthreads();
    {
        double pr = lbr_d, pi = lbi_d;
#pragma unroll
        for (int s = 0; s < 8; ++s) { const double t = pr * pr - pi * pi; pi = 2.0 * pr * pi; pr = t; }
        const float l256r = (float)pr, l256i = (float)pi;
        float cr = 0.f, ci = 0.f;
        for (int ww = 0; ww < w; ++ww) { const float er = ERE[ww * 64 + n], ei = EIM[ww * 64 + n]; const float t = l256r * cr - l256i * ci + er; ci = l256r * ci + l256i * cr + ei; cr = t; }
        xr = cr; xi = ci;
    }
    float dco[4];
#pragma unroll
    for (int k = 0; k < 4; ++k) dco[k] = F.a->in[I_S5D][16 * g + 4 * q + k];
#pragma unroll 1
    for (int blk = 0; blk < 16; ++blk) {
        const v2u raw = *(const GAS v2u*)(s5in + (rowbase + blk * 16 + tok) * 512 + 16 * g + 4 * q);
        *(LAS f32x4*)(UB + tok * 16 + 4 * q) = (f32x4){bflo(raw.x), bfhi(raw.x), bflo(raw.y), bfhi(raw.y)};
        LDS_WAIT();
#pragma unroll 2
        for (int i = 0; i < 16; ++i) {
            float u[16];
#pragma unroll
            for (int k = 0; k < 4; ++k) { const f32x4 t = *(const LAS f32x4*)(UB + i * 16 + 4 * k); u[4 * k] = t.x; u[4 * k + 1] = t.y; u[4 * k + 2] = t.z; u[4 * k + 3] = t.w; }
            float bur = 0.f, bui = 0.f;
#pragma unroll
            for (int c = 0; c < 16; ++c) { bur += P.bbr[c] * u[c]; bui += P.bbi[c] * u[c]; }
            const float nr = P.lbr * xr - P.lbi * xi + bur, ni = P.lbr * xi + P.lbi * xr + bui; xr = nr; xi = ni;
            XRE[i * 68 + n] = xr; XIM[i * 68 + n] = xi;
        }
        LDS_WAIT();
        float acc[4] = {0.f, 0.f, 0.f, 0.f};
#pragma unroll 2
        for (int n4 = 0; n4 < 16; ++n4) {
            const f32x4 a = *(const LAS f32x4*)(XRE + tok * 68 + 4 * n4), bb = *(const LAS f32x4*)(XIM + tok * 68 + 4 * n4);
#pragma unroll
            for (int k = 0; k < 4; ++k) { const f32x4 cr = *(const LAS f32x4*)(CRE + (4 * q + k) * 68 + 4 * n4), ci = *(const LAS f32x4*)(CIM + (4 * q + k) * 68 + 4 * n4);
                acc[k] += (cr.x * a.x + cr.y * a.y + cr.z * a.z + cr.w * a.w) - (ci.x * bb.x + ci.y * bb.y + ci.z * bb.z + ci.w * bb.w); }
        }
        const f32x4 uu = *(const LAS f32x4*)(UB + tok * 16 + 4 * q);
        const float z0 = gelu_tanh(acc[0] + dco[0] * uu.x), z1 = gelu_tanh(acc[1] + dco[1] * uu.y), z2 = gelu_tanh(acc[2] + dco[2] * uu.z), z3 = gelu_tanh(acc[3] + dco[3] * uu.w);
        *(GAS v2u*)(Z + (rowbase + blk * 16 + tok) * 512 + 16 * g + 4 * q) = (v2u){pk2(z0, z1), pk2(z2, z3)};
        LDS_WAIT();
    }
    if (w == 7) { F.a->out[O_S5RE_P + (size_t)(b * 32 + g) * 64 + n] = xr; F.a->out[O_S5IM_P + (size_t)(b * 32 + g) * 64 + n] = xi; }
    __syncthreads();
}
__device__ __forceinline__ void s5_sample_unit(Frame& F, int bs) {
    const int n = F.lane;
    const bf16* s5in = (const bf16*)(F.a->ws + WS_S5IN); bf16* Z = (bf16*)(F.a->ws + WS_Z);
    const size_t row = (size_t)MP + bs;
    for (int gi = 0; gi < 4; ++gi) {
        const int g = 4 * F.wave + gi;
        S5Par P;
        { const f32x4 pn = *(const GAS f32x4*)((const float*)(F.a->ws + WS_S5PAR) + (size_t)(g * 64 + n) * 8);
          P.lbr = pn.x; P.lbi = pn.y;
          const float* bre = F.a->in[I_BRE] + (size_t)(g * 64 + n) * 16; const float* bim = F.a->in[I_BIM] + (size_t)(g * 64 + n) * 16;
#pragma unroll
          for (int c = 0; c < 16; ++c) { const float br = bre[c], bi = bim[c]; P.bbr[c] = pn.z * br - pn.w * bi; P.bbi[c] = pn.z * bi + pn.w * br; } }
        float u[16];
#pragma unroll
        for (int c = 0; c < 16; ++c) u[c] = bf2f(s5in[row * 512 + 16 * g + c]);
        float bur = 0.f, bui = 0.f;
#pragma unroll
        for (int c = 0; c < 16; ++c) { bur += P.bbr[c] * u[c]; bui += P.bbi[c] * u[c]; }
        const float hr = F.a->in[I_S5RE][(size_t)(bs * 32 + g) * 64 + n], hi = F.a->in[I_S5IM][(size_t)(bs * 32 + g) * 64 + n];
        const float xr = P.lbr * hr - P.lbi * hi + bur, xi = P.lbr * hi + P.lbi * hr + bui;
        F.a->out[O_S5RE_S + (size_t)(bs * 32 + g) * 64 + n] = xr; F.a->out[O_S5IM_S + (size_t)(bs * 32 + g) * 64 + n] = xi;
        float myz = 0.f;
#pragma unroll
        for (int c = 0; c < 16; ++c) {
            const float y = wave_sum(F.a->in[I_CRE][(size_t)(g * 16 + c) * 64 + n] * xr - F.a->in[I_CIM][(size_t)(g * 16 + c) * 64 + n] * xi);
            const float z = gelu_tanh(y + F.a->in[I_S5D][16 * g + c] * u[c]);
            if (n == c) myz = z;
        }
        if (n < 16) Z[row * OZP + 16 * g + n] = (bf16)f2bf(myz);
    }
}

constexpr int RW_R = 0, RW_DEC = 4096, RW_KP = 8192, RW_V = 12288, RW_AA = 16384, RW_BB = 20480, RW_GG = 24576, RW_F32_END = 28672;
constexpr int RW_WD_B = RW_F32_END * 4, RW_AD_B = RW_WD_B + 8192, RW_GD_B = RW_AD_B + 8192, RW_BON_B = RW_GD_B + 16384, RW_END_B = RW_BON_B + 256;
static_assert(RW_END_B <= MISC_OFF, "rwkv LDS");

__device__ __forceinline__ void rwkv_prompt_unit(Frame& F, int b, int h) {
    LAS float* L = (LAS float*)F.lds;
    LAS bf16* WD = (LAS bf16*)(F.lds + RW_WD_B); LAS bf16* AD = (LAS bf16*)(F.lds + RW_AD_B); LAS bf16* GD = (LAS bf16*)(F.lds + RW_GD_B);
    LAS float* BON = (LAS float*)(F.lds + RW_BON_B);
    const bf16* cur = (const bf16*)(F.a->ws + WS_CUR); bf16* O = (bf16*)(F.a->ws + WS_O);
    const float* mu = F.a->in[I_MU];
    float S[64];
#pragma unroll
    for (int j = 0; j < 64; ++j) S[j] = 0.f;
    const int t_ = F.tid >> 3, jg = F.tid & 7, hc = 64 * h + 8 * jg;
    for (int ch = 0; ch < SEQ / 64; ++ch) {
        const int t0 = ch * 64;
        for (int it = 0; it < 7; ++it) {
            const int item = it * 512 + F.tid, t = item / 56, vi = item % 56;
            const int col = vi < 8 ? 64 * h + 8 * vi : vi < 16 ? 512 + 64 * h + 8 * (vi - 8) : vi < 24 ? 1024 + 64 * h + 8 * (vi - 16) : 1536 + 8 * (vi - 24);
            const size_t row = (size_t)b * SEQ + t0 + t;
            const v4u c = *(const GAS v4u*)(cur + row * NSHIFT + col);
            v4u p = (v4u){0u, 0u, 0u, 0u};
            if (t0 + t > 0) p = *(const GAS v4u*)(cur + (row - 1) * NSHIFT + col);
            const f32x4 m0 = *(const GAS f32x4*)(mu + col), m1 = *(const GAS f32x4*)(mu + col + 4);
            float x[8];
            { const float c0 = bflo(c.x), c1 = bfhi(c.x), c2 = bflo(c.y), c3 = bfhi(c.y), c4 = bflo(c.z), c5 = bfhi(c.z), c6 = bflo(c.w), c7 = bfhi(c.w);
              x[0] = c0 + m0.x * (bflo(p.x) - c0); x[1] = c1 + m0.y * (bfhi(p.x) - c1); x[2] = c2 + m0.z * (bflo(p.y) - c2); x[3] = c3 + m0.w * (bfhi(p.y) - c3);
              x[4] = c4 + m1.x * (bflo(p.z) - c4); x[5] = c5 + m1.y * (bfhi(p.z) - c5); x[6] = c6 + m1.z * (bflo(p.w) - c6); x[7] = c7 + m1.w * (bfhi(p.w) - c7); }
            if (vi < 24) {
                LAS float* dst = L + (vi < 8 ? RW_R : vi < 16 ? RW_KP : RW_V) + t * 64 + 8 * (vi & 7);
                *(LAS f32x4*)dst = (f32x4){x[0], x[1], x[2], x[3]}; *(LAS f32x4*)(dst + 4) = (f32x4){x[4], x[5], x[6], x[7]};
            } else {
                const int m = 8 * (vi - 24);
                if (m < 64) { _Pragma("unroll") for (int i = 0; i < 8; ++i) x[i] = tanhf_(x[i]); *(LAS v4u*)(WD + t * 64 + m) = (v4u){pk2(x[0], x[1]), pk2(x[2], x[3]), pk2(x[4], x[5]), pk2(x[6], x[7])}; }
                else if (m < 128) { *(LAS v4u*)(AD + t * 64 + (m - 64)) = (v4u){pk2(x[0], x[1]), pk2(x[2], x[3]), pk2(x[4], x[5]), pk2(x[6], x[7])}; }
                else { _Pragma("unroll") for (int i = 0; i < 8; ++i) x[i] = sigmoidf_(x[i]); *(LAS v4u*)(GD + t * 128 + (m - 128)) = (v4u){pk2(x[0], x[1]), pk2(x[2], x[3]), pk2(x[4], x[5]), pk2(x[6], x[7])}; }
            }
        }
        __syncthreads();
        {
            float aw[8], aa[8], ag[8];
            { const f32x4 w0a = *(const GAS f32x4*)(F.a->in[I_W0] + hc), w0b = *(const GAS f32x4*)(F.a->in[I_W0] + hc + 4), a0a = *(const GAS f32x4*)(F.a->in[I_A0] + hc), a0b = *(const GAS f32x4*)(F.a->in[I_A0] + hc + 4);
              aw[0] = w0a.x; aw[1] = w0a.y; aw[2] = w0a.z; aw[3] = w0a.w; aw[4] = w0b.x; aw[5] = w0b.y; aw[6] = w0b.z; aw[7] = w0b.w;
              aa[0] = a0a.x; aa[1] = a0a.y; aa[2] = a0a.z; aa[3] = a0a.w; aa[4] = a0b.x; aa[5] = a0b.y; aa[6] = a0b.z; aa[7] = a0b.w; }
#pragma unroll
            for (int i = 0; i < 8; ++i) ag[i] = 0.f;
            for (int m = 0; m < 64; ++m) {
                const float wd = bf2f(WD[t_ * 64 + m]), ad = bf2f(AD[t_ * 64 + m]);
                const f32x4 w2a = *(const GAS f32x4*)(F.a->in[I_W2] + m * 512 + hc), w2b = *(const GAS f32x4*)(F.a->in[I_W2] + m * 512 + hc + 4);
                const f32x4 a2a = *(const GAS f32x4*)(F.a->in[I_A2] + m * 512 + hc), a2b = *(const GAS f32x4*)(F.a->in[I_A2] + m * 512 + hc + 4);
                aw[0] += wd * w2a.x; aw[1] += wd * w2a.y; aw[2] += wd * w2a.z; aw[3] += wd * w2a.w; aw[4] += wd * w2b.x; aw[5] += wd * w2b.y; aw[6] += wd * w2b.z; aw[7] += wd * w2b.w;
                aa[0] += ad * a2a.x; aa[1] += ad * a2a.y; aa[2] += ad * a2a.z; aa[3] += ad * a2a.w; aa[4] += ad * a2b.x; aa[5] += ad * a2b.y; aa[6] += ad * a2b.z; aa[7] += ad * a2b.w;
            }
            for (int m = 0; m < 128; ++m) {
                const float gd = bf2f(GD[t_ * 128 + m]);
                const f32x4 g2a = *(const GAS f32x4*)(F.a->in[I_G2] + m * 512 + hc), g2b = *(const GAS f32x4*)(F.a->in[I_G2] + m * 512 + hc + 4);
                ag[0] += gd * g2a.x; ag[1] += gd * g2a.y; ag[2] += gd * g2a.z; ag[3] += gd * g2a.w; ag[4] += gd * g2b.x; ag[5] += gd * g2b.y; ag[6] += gd * g2b.z; ag[7] += gd * g2b.w;
            }
            float kkv[8], ss = 0.f, bon = 0.f, kp[8], al[8];
#pragma unroll
            for (int i = 0; i < 8; ++i) {
                const float w = -softplusf_(-aw[i]) - 0.5f;
                L[RW_DEC + t_ * 64 + 8 * jg + i] = __expf(-__expf(w));
                al[i] = sigmoidf_(aa[i]);
                const float k = L[RW_KP + t_ * 64 + 8 * jg + i];
                kkv[i] = k * F.a->in[I_KK][hc + i]; ss += kkv[i] * kkv[i];
                kp[i] = k * (1.0f + (al[i] - 1.0f) * F.a->in[I_KA][hc + i]);
                bon += L[RW_R + t_ * 64 + 8 * jg + i] * kp[i] * F.a->in[I_RK][hc + i];
            }
            ss += __shfl_xor(ss, 1); ss += __shfl_xor(ss, 2); ss += __shfl_xor(ss, 4);
            bon += __shfl_xor(bon, 1); bon += __shfl_xor(bon, 2); bon += __shfl_xor(bon, 4);
            const float inv = 1.0f / fmaxf(sqrtf(ss), 1e-12f);
#pragma unroll
            for (int i = 0; i < 8; ++i) {
                const float kn = kkv[i] * inv;
                L[RW_KP + t_ * 64 + 8 * jg + i] = kp[i]; L[RW_AA + t_ * 64 + 8 * jg + i] = -kn; L[RW_BB + t_ * 64 + 8 * jg + i] = kn * al[i]; L[RW_GG + t_ * 64 + 8 * jg + i] = ag[i];
            }
            if (jg == 0) BON[t_] = bon;
        }
        __syncthreads();
        if (F.wave == 0) {
            for (int t = 0; t < 64; ++t) {
                float sa = 0.f;
#pragma unroll
                for (int j4 = 0; j4 < 16; ++j4) { const f32x4 a = *(const LAS f32x4*)(L + RW_AA + t * 64 + 4 * j4); sa += S[4 * j4] * a.x + S[4 * j4 + 1] * a.y + S[4 * j4 + 2] * a.z + S[4 * j4 + 3] * a.w; }
                const float vv = L[RW_V + t * 64 + F.lane];
                float y = 0.f;
#pragma unroll
                for (int j4 = 0; j4 < 16; ++j4) {
                    const f32x4 d = *(const LAS f32x4*)(L + RW_DEC + t * 64 + 4 * j4), bb = *(const LAS f32x4*)(L + RW_BB + t * 64 + 4 * j4), kk = *(const LAS f32x4*)(L + RW_KP + t * 64 + 4 * j4), rr = *(const LAS f32x4*)(L + RW_R + t * 64 + 4 * j4);
                    S[4 * j4] = S[4 * j4] * d.x + sa * bb.x + vv * kk.x; S[4 * j4 + 1] = S[4 * j4 + 1] * d.y + sa * bb.y + vv * kk.y;
                    S[4 * j4 + 2] = S[4 * j4 + 2] * d.z + sa * bb.z + vv * kk.z; S[4 * j4 + 3] = S[4 * j4 + 3] * d.w + sa * bb.w + vv * kk.w;
                    y += S[4 * j4] * rr.x + S[4 * j4 + 1] * rr.y + S[4 * j4 + 2] * rr.z + S[4 * j4 + 3] * rr.w;
                }
                LDS_WAIT();
                L[RW_R + t * 64 + F.lane] = y;
            }
        }
        __syncthreads();
        {
            float y[8], s = 0.f;
#pragma unroll
            for (int i = 0; i < 8; ++i) { y[i] = L[RW_R + t_ * 64 + 8 * jg + i]; s += y[i]; }
            s += __shfl_xor(s, 1); s += __shfl_xor(s, 2); s += __shfl_xor(s, 4);
            const float mean = s * (1.0f / 64.0f); float q = 0.f;
#pragma unroll
            for (int i = 0; i < 8; ++i) { y[i] -= mean; q += y[i] * y[i]; }
            q += __shfl_xor(q, 1); q += __shfl_xor(q, 2); q += __shfl_xor(q, 4);
            const float rstd = 1.0f / sqrtf(q * (1.0f / 64.0f) + GN_EPS), bon = BON[t_];
            float o[8];
#pragma unroll
            for (int i = 0; i < 8; ++i) o[i] = (y[i] * rstd * F.a->in[I_LNW][hc + i] + F.a->in[I_LNB][hc + i] + bon * L[RW_V + t_ * 64 + 8 * jg + i]) * L[RW_GG + t_ * 64 + 8 * jg + i];
            *(GAS v4u*)(O + ((size_t)b * SEQ + t0 + t_) * 512 + hc) = (v4u){pk2(o[0], o[1]), pk2(o[2], o[3]), pk2(o[4], o[5]), pk2(o[6], o[7])};
        }
        __syncthreads();
    }
    if (F.wave == 0) {
        float* so = F.a->out + O_WKV_P + ((size_t)(b * 8 + h) * 64 + F.lane) * 64;
#pragma unroll
        for (int j4 = 0; j4 < 16; ++j4) *(GAS f32x4*)(so + 4 * j4) = (f32x4){S[4 * j4], S[4 * j4 + 1], S[4 * j4 + 2], S[4 * j4 + 3]};
    }
}
__device__ __forceinline__ void rwkv_sample_unit(Frame& F, int bs) {
    const int h = F.wave, j = F.lane, hc = 64 * h + j;
    LAS float* LX = (LAS float*)F.lds + F.wave * 1024;
    LAS float* VA = LX + 256; LAS float* VB = VA + 64; LAS float* VD = VB + 64; LAS float* VK = VD + 64; LAS float* VR = VK + 64;
    const bf16* cur = (const bf16*)(F.a->ws + WS_CUR) + ((size_t)MP + bs) * NSHIFT; bf16* O = (bf16*)(F.a->ws + WS_O);
    const float* prev = F.a->in[I_SHIFT] + (size_t)bs * NSHIFT; const float* mu = F.a->in[I_MU];
#define MIXC(col) ({ const float c_ = bf2f(cur[(col)]); c_ + mu[(col)] * (prev[(col)] - c_); })
#pragma unroll
    for (int q = 0; q < 4; ++q) { const int m = j + 64 * q; float x = MIXC(1536 + m); x = q == 0 ? tanhf_(x) : (q == 1 ? x : sigmoidf_(x)); LX[m] = x; }
    const float r = MIXC(hc), k = MIXC(512 + hc), v = MIXC(1024 + hc);
#undef MIXC
    LDS_WAIT();
    float aw = F.a->in[I_W0][hc], aa = F.a->in[I_A0][hc], ag = 0.f;
#pragma unroll 16
    for (int m = 0; m < 64; ++m) { aw += LX[m] * F.a->in[I_W2][m * 512 + hc]; aa += LX[64 + m] * F.a->in[I_A2][m * 512 + hc]; }
#pragma unroll 32
    for (int m = 0; m < 128; ++m) ag += LX[128 + m] * F.a->in[I_G2][m * 512 + hc];
    const float w = -softplusf_(-aw) - 0.5f, dec = __expf(-__expf(w)), al = sigmoidf_(aa);
    const float kkv = k * F.a->in[I_KK][hc], nrm = fmaxf(sqrtf(wave_sum(kkv * kkv)), 1e-12f), kn = kkv / nrm;
    const float kp = k * (1.0f + (al - 1.0f) * F.a->in[I_KA][hc]);
    const float bon = wave_sum(r * kp * F.a->in[I_RK][hc]);
    VA[j] = -kn; VB[j] = kn * al; VD[j] = dec; VK[j] = kp; VR[j] = r;
    LDS_WAIT();
    asm volatile("" ::: "memory");
    const float* s0 = F.a->in[I_WKV] + ((size_t)(bs * 8 + h) * 64 + j) * 64;
    float* s1 = F.a->out + O_WKV_S + ((size_t)(bs * 8 + h) * 64 + j) * 64;
    float S[64];
#pragma unroll
    for (int j4 = 0; j4 < 16; ++j4) { const f32x4 t = *(const GAS f32x4*)(s0 + 4 * j4); S[4 * j4] = t.x; S[4 * j4 + 1] = t.y; S[4 * j4 + 2] = t.z; S[4 * j4 + 3] = t.w; }
    float sa = 0.f;
#pragma unroll
    for (int j4 = 0; j4 < 16; ++j4) { const f32x4 a = *(const LAS f32x4*)(VA + 4 * j4); sa += S[4 * j4] * a.x + S[4 * j4 + 1] * a.y + S[4 * j4 + 2] * a.z + S[4 * j4 + 3] * a.w; }
    float y = 0.f;
#pragma unroll
    for (int j4 = 0; j4 < 16; ++j4) {
        const f32x4 d = *(const LAS f32x4*)(VD + 4 * j4), bb = *(const LAS f32x4*)(VB + 4 * j4), kk = *(const LAS f32x4*)(VK + 4 * j4), rr = *(const LAS f32x4*)(VR + 4 * j4);
        S[4 * j4] = S[4 * j4] * d.x + sa * bb.x + v * kk.x; S[4 * j4 + 1] = S[4 * j4 + 1] * d.y + sa * bb.y + v * kk.y;
        S[4 * j4 + 2] = S[4 * j4 + 2] * d.z + sa * bb.z + v * kk.z; S[4 * j4 + 3] = S[4 * j4 + 3] * d.w + sa * bb.w + v * kk.w;
        y += S[4 * j4] * rr.x + S[4 * j4 + 1] * rr.y + S[4 * j4 + 2] * rr.z + S[4 * j4 + 3] * rr.w;
        asm volatile("" ::: "memory");
    }
#pragma unroll
    for (int j4 = 0; j4 < 16; ++j4) *(GAS f32x4*)(s1 + 4 * j4) = (f32x4){S[4 * j4], S[4 * j4 + 1], S[4 * j4 + 2], S[4 * j4 + 3]};
    const float mean = wave_sum(y) * (1.0f / 64.0f), dy = y - mean, var = wave_sum(dy * dy) * (1.0f / 64.0f);
    const float o = (dy * (1.0f / sqrtf(var + GN_EPS)) * F.a->in[I_LNW][hc] + F.a->in[I_LNB][hc] + bon * v) * ag;
    O[((size_t)MP + bs) * OZP + hc] = (bf16)f2bf(o);
    LDS_WAIT();
}
#define MIX_LOOP(lo_, hi_, first_, stride_, call_) _Pragma("unroll 1") for (int u = (lo_) + (first_); u < (hi_); u += (stride_)) { Frame Fu = F; asm volatile("" : "+v"(Fu.tid)); Fu.lane = Fu.tid & 63; call_; __syncthreads(); }
#ifndef PROBE_MIX
#define PROBE_MIX 0
#endif
__device__ __forceinline__ void mixer_phase1(Frame& F) {
    MIX_LOOP(0, 256, F.bid, F.G, rwkvA_unit(Fu, u >> 5, u & 31))
    if (PROBE_MIX == 1) { MIX_LOOP(0, 256, F.bid, F.G, rwkvA_unit(Fu, u >> 5, u & 31)) }
}
__device__ __forceinline__ void mixer_phase2(Frame& F) {
    if (F.G >= 128) {
        if (F.bid < 64) { MIX_LOOP(0, 64, F.bid, 64, rwkvB_unit(Fu, u >> 3, u & 7, (bf16*)(F.a->ws + WS_O), ~(size_t)0))
            if (PROBE_MIX == 5) { MIX_LOOP(0, 64, F.bid, 64, rwkvB_unit(Fu, u >> 3, u & 7, (bf16*)(F.a->ws + WS_BON + 1 * MiB), (size_t)2047)) } }
        else {
            if ((F.G - 64) % 32 == 0) { const int u0 = F.bid - 64; if (u0 < 256) s5_prompt_unit2(F, u0 >> 5, u0 & 31, (F.G - 64) / 32); }
            else { MIX_LOOP(0, 256, F.bid - 64, F.G - 64, s5_prompt_unit2(Fu, u >> 5, u & 31, 8)) }
            MIX_LOOP(0, 128, F.G - 1 - F.bid, F.G - 64, s5_sample_unit(Fu, u)) MIX_LOOP(0, 128, F.G - 1 - F.bid, F.G - 64, rwkv_sample_unit(Fu, u))
            if (PROBE_MIX == 2) { MIX_LOOP(0, 256, F.bid - 64, F.G - 64, s5_prompt_unit2(Fu, u >> 5, u & 31, 8)) }
        }
    } else {
        MIX_LOOP(0, 64, F.bid, F.G, rwkvB_unit(Fu, u >> 3, u & 7, (bf16*)(F.a->ws + WS_O), ~(size_t)0)) MIX_LOOP(0, 256, F.bid, F.G, s5_prompt_unit2(Fu, u >> 5, u & 31, 8))
        MIX_LOOP(0, 128, F.bid, F.G, s5_sample_unit(Fu, u)) MIX_LOOP(0, 128, F.bid, F.G, rwkv_sample_unit(Fu, u))
    }
    const bf16* cur = (const bf16*)(F.a->ws + WS_CUR);
    for (int i = F.bid * 512 + F.tid; i < NB * NSHIFT; i += F.G * 512) {
        const int b = i / NSHIFT, c = i % NSHIFT;
        if (b < 8) F.a->out[O_SHIFT_P + (size_t)b * NSHIFT + c] = bf2f(cur[((size_t)b * SEQ + SEQ - 1) * NSHIFT + c]);
        else F.a->out[O_SHIFT_S + (size_t)(b - 8) * NSHIFT + c] = bf2f(cur[((size_t)MP + (b - 8)) * NSHIFT + c]);
    }
}
#undef MIX_LOOP

#ifndef MK_N_LAUNCHES
#define MK_N_LAUNCHES 1
#endif
constexpr int N_PHASES = 14;

__global__ void __launch_bounds__(NWAVES * 64, 2) fwd_kernel(Args args) {
    extern __shared__ __attribute__((aligned(16))) unsigned char lds[];
    Frame F;
    F.lds = (LAS unsigned char*)lds;
    F.tid = threadIdx.x; F.lane = F.tid & 63; F.wave = __builtin_amdgcn_readfirstlane(F.tid >> 6);
    F.G = gridDim.x; F.bid = blockIdx.x;
    F.a = &args;
    unsigned char* ws = args.ws;
    volatile LAS unsigned* MISC = (volatile LAS unsigned*)(F.lds + MISC_OFF);
    if (F.tid < 64) MISC[F.tid] = 0u;
    __syncthreads();
    XcdBarrier bar; bar.bar = (unsigned*)(ws + WS_CTL) + 4096; bar.x = 0; bar.st = nullptr;
    const int lo = args.ph_lo, hi = args.ph_hi;
    if (hi - lo > 1) bar = xcd_barrier_post((unsigned*)(ws + WS_CTL) + 4096, MISC + 8);
#ifndef PHASE_MASK
#define PHASE_MASK 0xFFFFF
#endif
#define IN(k) (((PHASE_MASK >> (k)) & 1) && lo <= (k) && (k) < hi)
#ifndef BAR_IMPL
#define BAR_IMPL xcd_barrier3
#endif
#define SEAM(k) do { if (IN(k) && IN((k) + 1)) BAR_IMPL(bar); } while (0)
#ifndef PROBE_DUP
#define PROBE_DUP -1
#endif
#define RUN(k, ...) if (IN(k)) { __VA_ARGS__ if (PROBE_DUP == (k)) { BAR_IMPL(bar); __VA_ARGS__ } } SEAM(k);
    const float* mod = (const float*)(ws + WS_MOD);
    float* H = F.a->out + O_Y;
    bf16* HB = (bf16*)H + 1024;
    bf16* XN = (bf16*)(ws + WS_XN);
    bf16* HID = (bf16*)(ws + WS_BIG);
    float* SLAB = (float*)(ws + WS_SLAB);
    float* RSP = (float*)(ws + WS_SLAB); float* RSD = (float*)(ws + WS_SLAB + MiB); float* OBUF = (float*)(ws + WS_SLAB + 2 * MiB);
    unsigned* FLG = (unsigned*)(ws + WS_CTL) + 10240;
    bf16* MM = (bf16*)(ws + WS_S5IN);
    const int bid = (int)blockIdx.x;

    RUN(0, p0_prologue(F, 0, 0); s5_par_prologue(F);)
#ifdef PROBE_S5PAR
    if (IN(0)) { s5_par_prologue(F); BAR_IMPL(bar); }
#endif
    RUN(1, pg8::Gemm g{{(const bf16*)(ws + WS_SC)}, {(const bf16*)(ws + WS_WADA)}, 256, NMOD, D, D}; pg8::StaticOrder S; S.init(256, NMOD, F.G, bid);
        pg8::EpiMod E{(float*)(ws + WS_MOD), F.a->in[I_BADA]};
        pg8::gemm_phase<pg8::EpiMod, pg8::StaticOrder, true, true>(F.lds, g, S, E);
        __syncthreads(); p0_prologue(F, 1, F.G >= 72 ? 36 : 0);)
#ifdef PROBE_P1
#if PROBE_P1 == 3
    if (IN(1)) { pg8::Gemm g{{(const bf16*)(ws + WS_SC)}, {(const bf16*)(ws + WS_WADA)}, 256, NMOD, D, D}; pg8::StaticOrder S; S.init(256, NMOD, F.G, bid);
        pg8::EpiMod E{(float*)(ws + WS_MOD), F.a->in[I_BADA]};
        pg8::gemm_phase<pg8::EpiMod, pg8::StaticOrder, true, true>(F.lds, g, S, E); BAR_IMPL(bar); }
#else
    if (IN(1)) { p0_prologue(F, 1, PROBE_P1 == 1 ? 36 : 0); BAR_IMPL(bar); }
#endif
#endif
#ifdef PROBE_BAR
#if PROBE_BAR == 1
    for (int i_ = 0; i_ < 8; ++i_) xcd_barrier(bar);
#elif PROBE_BAR == 4
    for (int i_ = 0; i_ < 8; ++i_) xcd_barrier2(bar);
#else
    for (int i_ = 0; i_ < 8; ++i_) {
        unsigned* ctr = (unsigned*)(ws + WS_CTL) + 8192;
        asm volatile("s_waitcnt vmcnt(0)" ::: "memory"); __syncthreads();
        if (threadIdx.x == 0) {
#if PROBE_BAR != 3
            __builtin_amdgcn_fence(__ATOMIC_RELEASE, "agent"); asm volatile("s_waitcnt vmcnt(0)" ::: "memory");
#endif
            __hip_atomic_fetch_add(ctr, 1u, __ATOMIC_RELAXED, __HIP_MEMORY_SCOPE_AGENT);
            const unsigned target = (unsigned)(i_ + 1) * gridDim.x; unsigned sp = 0;
            while (__hip_atomic_load(ctr, __ATOMIC_RELAXED, __HIP_MEMORY_SCOPE_AGENT) < target) { __builtin_amdgcn_s_sleep(1); if (++sp > (1u << 20)) break; }
#if PROBE_BAR != 3
            __builtin_amdgcn_fence(__ATOMIC_ACQUIRE, "agent"); asm volatile("s_waitcnt vmcnt(0)" ::: "memory");
#endif
        }
        __syncthreads();
    }
#endif
#endif
    RUN(2, norm_phase<false, true>(F, F.a->in[I_XP], F.a->in[I_XS], HB, F.a->in[I_GFFN1], 0, 1, XN, nullptr, nullptr, 0);)
    RUN(3, pg8::Gemm g{{XN}, {(const bf16*)(ws + WS_W13_1)}, MPAD, 2 * DFF, D / 2, D / 2}; pg8::StaticOrder S; S.init(MPAD, 2 * DFF, F.G, bid);
        pg8::EpiSwiglu8 E{(unsigned char*)HID, DFF};
        pg8::gemm_phase<pg8::EpiSwiglu8, pg8::StaticOrder, true, true, true>(F.lds, g, S, E);)
    RUN(4, dec_proj_part1_f8(F, bid, (const unsigned char*)HID, ws + WS_W2_1, HB, 2, 0.5f * pg8::F8_INV_DN, RSD, FLG + 1024, OBUF, false);
        pg8::Gemm g{{HID}, {(const bf16*)(ws + WS_W2_1)}, MPAD, D, DFF / 2, DFF / 2}; pg8::StaticOrder S; S.init(MP, D, F.G, bid);
        pg8::EpiResNorm E{F.a->in[I_XP], HB, mod, 2, 0.5f * pg8::F8_INV_DN, RSP, FLG, F.a->in[I_GMIX], 3, 4, XN, nullptr, false, (unsigned char*)H};
        pg8::gemm_phase<pg8::EpiResNorm, pg8::StaticOrder, true, true, true>(F.lds, g, S, E);
        dec_proj_part2(F, bid, RSD, FLG + 1024, OBUF, F.a->in[I_GMIX], 3, 4, XN, nullptr);)
    RUN(6, pg8::Gemm g{{XN}, {(const bf16*)(ws + WS_WIN)}, MPAD, NIN, D, D}; pg8::ExtOrder S; S.init2(MPAD, 2304, F.G, bid, 8, MP / 256, 9);
        pg8::EpiWin E{(bf16*)(ws + WS_S5IN), (bf16*)(ws + WS_CUR), (bf16*)(ws + WS_GATES), 0};
        pg8::gemm_phase<pg8::EpiWin, pg8::ExtOrder, true, true>(F.lds, g, S, E);
        { const int wg2 = F.G == 256 ? 81 : 0;
          if (bid >= wg2) { __syncthreads(); p0_prologue(F, 2, wg2); } })
    RUN(7, mixer_phase1(F);)
    RUN(8, mixer_phase2(F);)
    RUN(9, for (int s_ = bid; s_ < 256; s_ += F.G) sample_mix_unit(F, s_);
        { pg8::Gemm g8{{(const bf16*)H}, {(const bf16*)(ws + WS_WIN8 - (size_t)9 * 256 * 4096)}, MPAD, 0, D / 2, 2048};
          int md1 = 1; asm volatile("" : "+s"(md1));
          pg8::ChainOrder S8; S8.init(F.G, bid, MP / 256, md1);
          pg8::EpiWin E8{(bf16*)(ws + WS_S5IN), (bf16*)(ws + WS_CUR), (bf16*)(ws + WS_GATES), 0, pg8::F8_INV_UP};
          pg8::gemm_phase<pg8::EpiWin, pg8::ChainOrder, true, true, true>(F.lds, g8, S8, E8); }
        __syncthreads();
        pg8::Gemm g{{XN, (const bf16*)(ws + WS_OZ), (const bf16*)(ws + WS_OZ)}, {(const bf16*)(ws + WS_WIN), (const bf16*)(ws + WS_GPT), (const bf16*)(ws + WS_GPT)}, MPAD, 0, D, D};
        int md2 = 2; asm volatile("" : "+s"(md2));
        pg8::ChainOrder S; S.init(F.G, bid, MP / 256, md2);
        pg8::EpiChain E{{(bf16*)(ws + WS_S5IN), (bf16*)(ws + WS_CUR), (bf16*)(ws + WS_GATES), 0}, {(const bf16*)(ws + WS_GATES), MM}, {(const bf16*)(ws + WS_GATES), MM, MM, (unsigned char*)H + 1024}};
        pg8::gemm_phase<pg8::EpiChain, pg8::ChainOrder, true, true>(F.lds, g, S, E);)
    RUN(10, dec_proj_part1<D>(F, bid, MM, D, (const bf16*)(ws + WS_WOUT), HB, 5, 1.0f, RSD + 128 * 64, FLG + 2048 + 1024, OBUF, false);
        pg8::Gemm g{{(const bf16*)((unsigned char*)H + 1024)}, {(const bf16*)(ws + WS_WIN8 + 1024)}, MPAD, D, D / 2, 2048}; pg8::StaticOrder S; S.init(MP, D, F.G, bid);
        pg8::EpiResNorm E{nullptr, HB, mod, 5, 1.0f * pg8::F8_INV_UP, RSP + 16384 * 4, FLG + 2048, F.a->in[I_GFFN2], 6, 7, XN, nullptr, true};
        pg8::gemm_phase<pg8::EpiResNorm, pg8::StaticOrder, true, true, true>(F.lds, g, S, E);
        dec_proj_part2(F, bid, RSD + 128 * 64, FLG + 2048 + 1024, OBUF, F.a->in[I_GFFN2], 6, 7, XN, nullptr, true);)
    RUN(12, pg8::Gemm g{{XN}, {(const bf16*)(ws + WS_W13_2)}, MPAD, 2 * DFF, D / 2, D / 2}; pg8::StaticOrder S; S.init(MPAD, 2 * DFF, F.G, bid);
        pg8::EpiSwiglu8 E{(unsigned char*)HID, DFF};
        pg8::gemm_phase<pg8::EpiSwiglu8, pg8::StaticOrder, true, true, true>(F.lds, g, S, E);)
    if (IN(13)) { dec_proj_part1_f8(F, bid, (const unsigned char*)HID, ws + WS_W2_2, HB, 8, 0.5f * pg8::F8_INV_DN, RSD + 2 * 128 * 64, FLG + 4096 + 1024, OBUF, true);
        { pg8::Gemm g{{HID}, {(const bf16*)(ws + WS_W2_2)}, MPAD, D, DFF / 2, DFF / 2}; pg8::StaticOrder S; S.init(MP, D, F.G, bid);
          pg8::EpiResNormFin E{nullptr, HB, mod, 8, 0.5f * pg8::F8_INV_DN, RSP + 2 * 16384 * 4, FLG + 4096, F.a->in[I_GFINAL], 0, 0, nullptr, H};
          pg8::gemm_phase<pg8::EpiResNormFin, pg8::StaticOrder, true, true, true>(F.lds, g, S, E); }
        dec_proj_part2(F, bid, RSD + 2 * 128 * 64, FLG + 4096 + 1024, OBUF, F.a->in[I_GFINAL], 0, 0, nullptr, H); }
#undef IN
#undef SEAM
}

extern "C" void kernel_launch(void* const* d_in, const int* in_sizes, int n_in, void* d_out, int out_size, void* d_ws, size_t ws_size, hipStream_t stream) {
    static int grid = 0;
    if (grid == 0) {
        if (n_in != N_IN_T || (size_t)out_size != O_TOTAL || ws_size < WS_END) { fprintf(stderr, "kernel_launch: unexpected shapes: n_in %d out %d ws %zu\n", n_in, out_size, ws_size); grid = -1; return; }
        int dev = 0, cus = 0, per_cu = 0;
        if (hipGetDevice(&dev) != hipSuccess || hipDeviceGetAttribute(&cus, hipDeviceAttributeMultiprocessorCount, dev) != hipSuccess) { grid = -1; return; }
        if (hipFuncSetAttribute((const void*)fwd_kernel, hipFuncAttributeMaxDynamicSharedMemorySize, LDS_BYTES) != hipSuccess) { fprintf(stderr, "kernel_launch: hipFuncSetAttribute failed\n"); grid = -1; return; }
        if (hipOccupancyMaxActiveBlocksPerMultiprocessor(&per_cu, (const void*)fwd_kernel, NWAVES * 64, LDS_BYTES) != hipSuccess || per_cu < 1) { fprintf(stderr, "kernel_launch: occupancy query says %d\n", per_cu); per_cu = 1; }
        (void)hipGetLastError();
        grid = cus;
        if (grid != 256) { fprintf(stderr, "kernel_launch: this kernel is laid out for the 256 CUs of an MI355X (found %d): the fused-norm phases wait across workgroups of one round\n", cus); grid = -1; return; }
    }
    if (grid < 0) return;
    (void)hipMemsetAsync((char*)d_ws + WS_CTL, 0, CTL_ZERO_BYTES, stream);
    Args a{};
    for (int i = 0; i < N_IN_T; ++i) a.in[i] = (const float*)d_in[i];
    a.out = (float*)d_out; a.ws = (unsigned char*)d_ws;
#if MK_N_LAUNCHES == 1
    a.ph_lo = 0; a.ph_hi = N_PHASES + 1;
    void* kargs[] = {&a};
    hipError_t e = hipLaunchCooperativeKernel((const void*)fwd_kernel, dim3(grid), dim3(NWAVES * 64), kargs, LDS_BYTES, stream);
    if (e != hipSuccess) fprintf(stderr, "kernel_launch: cooperative launch failed: %s\n", hipGetErrorString(e));
#else
    for (int p = 0; p <= N_PHASES; ++p) { a.ph_lo = p; a.ph_hi = p + 1; hipLaunchKernelGGL(fwd_kernel, dim3(grid), dim3(NWAVES * 64), LDS_BYTES, stream, a); }
#endif
}
```
